# Optimizing an MI355X kernel written in HIP

```python
import math
import jax, jax.numpy as jnp
from jax import lax
import numpy as np

D_MODEL = 1024
BATCH = 4
SEQ = 4096
DEPTH = 2

HEAD_DIM = 64
ROT_DIM = HEAD_DIM // 4
ROPE_THETA = 500000.0
Q_BLOCK = 128
EPS = 1e-6
NEG = -1e30
PLE_DIM = 256

DA_HEADS = 4
DA_QK = DA_HEADS * 2 * HEAD_DIM
DA_VDIM = 2 * HEAD_DIM
DA_WIDTH = DA_HEADS * DA_VDIM

DSA_HEADS = 8
DSA_WIDTH = DSA_HEADS * HEAD_DIM
IDX_HEADS = 8
IDX_DIM = 64
DSA_TOPK_MAX = 256

NSA_GROUPS = 2
NSA_HPG = 4
NSA_HEADS = NSA_GROUPS * NSA_HPG
NSA_WIDTH = NSA_HEADS * HEAD_DIM
KV_C = NSA_GROUPS * HEAD_DIM
CMP_LEN = 32
CMP_STRIDE = 16
CMP_HIDDEN = 128
SLC_BLOCK = 64
SLC_TOPN_MAX = 16
WINDOW = 512
FORCE_SCORE = 1e4

BRANCH_WIDTH = 512
N_BRANCH = 3

IN_SPLITS = (
    DA_QK, DA_QK, DA_WIDTH, BRANCH_WIDTH,
    DSA_WIDTH, HEAD_DIM, HEAD_DIM, BRANCH_WIDTH,
    IDX_HEADS * IDX_DIM, IDX_DIM, IDX_HEADS,
    NSA_WIDTH, KV_C, KV_C, KV_C, KV_C, KV_C, KV_C,
    BRANCH_WIDTH, NSA_HEADS * 3,
    N_BRANCH * D_MODEL,
)
N_IN = sum(IN_SPLITS)

kernel_name = "hybrid_diff_dsa_nsa_trunk"


def rmsnorm(x, g):
    xf = x.astype(jnp.float32)
    y = xf * lax.rsqrt(jnp.mean(xf * xf, axis=-1, keepdims=True) + EPS)
    return (y * g.astype(jnp.float32)).astype(x.dtype)


def masked_softmax(s, mask):
    s = jnp.where(mask, s.astype(jnp.float32), NEG)
    return jnp.where(mask, jax.nn.softmax(s, axis=-1), 0.0)


def rope_tables(positions):
    inv = ROPE_THETA ** (-jnp.arange(0, ROT_DIM, 2, dtype=jnp.float32) / ROT_DIM)
    ang = positions.astype(jnp.float32)[..., None] * inv
    return jnp.cos(ang), jnp.sin(ang)


def apply_rope(x, cos, sin):
    shp = cos.shape[:2] + (1,) * (x.ndim - 3) + cos.shape[2:]
    c = cos.reshape(shp).astype(x.dtype)
    s = sin.reshape(shp).astype(x.dtype)
    half = ROT_DIM // 2
    x1, x2 = x[..., :half], x[..., half:ROT_DIM]
    return jnp.concatenate([x1 * c - x2 * s, x2 * c + x1 * s, x[..., ROT_DIM:]], axis=-1)


def unblock(o):
    nb, b, qb = o.shape[:3]
    return jnp.moveaxis(o, 0, 1).reshape(b, nb * qb, -1)


def diff_attention(q, k, v, lam, subln_g, lam_init):
    S = q.shape[1]
    kpos = jnp.arange(S)
    scale = HEAD_DIM ** -0.5

    def block(i):
        q0 = i * Q_BLOCK
        tpos = q0 + jnp.arange(Q_BLOCK)
        qb = lax.dynamic_slice_in_dim(q, q0, Q_BLOCK, axis=1)
        s = jnp.einsum('bqhcd,bkhcd->bhcqk', qb, k).astype(jnp.float32) * scale
        pr = masked_softmax(s, kpos[None, :] <= tpos[:, None])
        a = pr[:, :, 0] - lam * pr[:, :, 1]
        return jnp.einsum('bhqk,bkhe->bqhe', a.astype(v.dtype), v)

    o = lax.map(block, jnp.arange(S // Q_BLOCK))
    b = q.shape[0]
    o = jnp.moveaxis(o, 0, 1).reshape(b, S, DA_HEADS, DA_VDIM)
    o = rmsnorm(o, subln_g) * (1.0 - lam_init)
    return o.reshape(b, S, DA_WIDTH)


def dsa_attention(q, k, v, iq, ik, iw, k_sel):
    S = q.shape[1]
    kpos = jnp.arange(S)
    scale = HEAD_DIM ** -0.5
    gather = jax.vmap(lambda kk, ii: kk[ii])

    def block(i):
        q0 = i * Q_BLOCK
        tpos = q0 + jnp.arange(Q_BLOCK)
        qb = lax.dynamic_slice_in_dim(q, q0, Q_BLOCK, axis=1)
        iqb = lax.dynamic_slice_in_dim(iq, q0, Q_BLOCK, axis=1)
        iwb = lax.dynamic_slice_in_dim(iw, q0, Q_BLOCK, axis=1).astype(jnp.float32) * IDX_HEADS ** -0.5
        dots = jnp.einsum('bqhd,bkd->bqhk', iqb, ik).astype(jnp.float32) * IDX_DIM ** -0.5
        score = jnp.einsum('bqh,bqhk->bqk', iwb, jax.nn.relu(dots))
        score = jnp.where(kpos[None, :] <= tpos[:, None], score, -jnp.inf)
        _, idx = lax.top_k(score, k_sel)
        valid = idx <= tpos[None, :, None]
        ksel = gather(k, idx)
        vsel = gather(v, idx)
        s = jnp.einsum('bqhd,bqkd->bqhk', qb, ksel).astype(jnp.float32) * scale
        pr = masked_softmax(s, valid[:, :, None, :])
        return jnp.einsum('bqhk,bqkd->bqhd', pr.astype(v.dtype), vsel)

    return unblock(lax.map(block, jnp.arange(S // Q_BLOCK)))


def compress(kv, pe, w1, w2):
    S = kv.shape[1]
    nc = (S - CMP_LEN) // CMP_STRIDE + 1
    idx = np.arange(nc)[:, None] * CMP_STRIDE + np.arange(CMP_LEN)[None, :]
    blocks = kv[:, idx] + pe[None, None, :, None, :]
    hid = jax.nn.gelu(jnp.einsum('bnlgd,ldf->bngf', blocks, w1))
    return jnp.einsum('bngf,fd->bngd', hid, w2)


def nsa_attention(q, q_rot, kc, vc, ks, vs, kw, vw, gates, n_sel):
    B, S = q.shape[:2]
    nc = kc.shape[1]
    n_blk = S // SLC_BLOCK
    scale = HEAD_DIM ** -0.5
    cstart = np.arange(nc) * CMP_STRIDE
    sstart = np.arange(n_blk) * SLC_BLOCK
    overlap = jnp.asarray(((cstart[:, None] < sstart[None, :] + SLC_BLOCK)
                           & (cstart[:, None] + CMP_LEN > sstart[None, :])).astype(np.float32))
    cmp_end = jnp.arange(nc) * CMP_STRIDE + CMP_LEN - 1
    blk = jnp.arange(n_blk)
    ks_blk = ks.reshape(B, n_blk, SLC_BLOCK, NSA_GROUPS, HEAD_DIM).transpose(0, 3, 1, 2, 4)
    vs_blk = vs.reshape(B, n_blk, SLC_BLOCK, NSA_GROUPS, HEAD_DIM).transpose(0, 3, 1, 2, 4)
    kw_pad = jnp.pad(kw, ((0, 0), (WINDOW, 0), (0, 0), (0, 0)))
    vw_pad = jnp.pad(vw, ((0, 0), (WINDOW, 0), (0, 0), (0, 0)))
    gather = jax.vmap(jax.vmap(lambda kb, ii: kb[ii]))

    def block(i):
        q0 = i * Q_BLOCK
        tpos = q0 + jnp.arange(Q_BLOCK)
        qb = lax.dynamic_slice_in_dim(q, q0, Q_BLOCK, axis=1)
        qrb = lax.dynamic_slice_in_dim(q_rot, q0, Q_BLOCK, axis=1)
        gb = jax.nn.sigmoid(lax.dynamic_slice_in_dim(gates, q0, Q_BLOCK, axis=1))
        sc = jnp.einsum('bqghd,bngd->bghqn', qb, kc).astype(jnp.float32) * scale
        pc = masked_softmax(sc, cmp_end[None, :] <= tpos[:, None])
        o_cmp = jnp.einsum('bghqn,bngd->bqghd', pc.astype(vc.dtype), vc)
        imp = jnp.einsum('bghqn,nm->bgqm', pc, overlap)
        forced = (blk[None, :] == (tpos // SLC_BLOCK)[:, None]) | (blk[None, :] == 0)
        imp = jnp.where(forced, FORCE_SCORE, imp)
        imp = jnp.where(blk[None, :] * SLC_BLOCK <= tpos[:, None], imp, -jnp.inf)
        _, sel = lax.top_k(imp, n_sel)
        ksel = gather(ks_blk, sel)
        vsel = gather(vs_blk, sel).reshape(B, NSA_GROUPS, Q_BLOCK, n_sel * SLC_BLOCK, HEAD_DIM)
        spos = sel[..., None] * SLC_BLOCK + jnp.arange(SLC_BLOCK)
        smask = (spos <= tpos[:, None, None]).reshape(B, NSA_GROUPS, Q_BLOCK, n_sel * SLC_BLOCK)
        ss = jnp.einsum('bqghd,bgqnjd->bghqnj', qrb, ksel).astype(jnp.float32) * scale
        ps = masked_softmax(ss.reshape(B, NSA_GROUPS, NSA_HPG, Q_BLOCK, n_sel * SLC_BLOCK), smask[:, :, None])
        o_slc = jnp.einsum('bghqk,bgqkd->bqghd', ps.astype(vsel.dtype), vsel)
        kwb = lax.dynamic_slice_in_dim(kw_pad, q0, Q_BLOCK + WINDOW, axis=1)
        vwb = lax.dynamic_slice_in_dim(vw_pad, q0, Q_BLOCK + WINDOW, axis=1)
        wpos = q0 - WINDOW + jnp.arange(Q_BLOCK + WINDOW)
        wmask = ((wpos[None, :] <= tpos[:, None]) & (wpos[None, :] > tpos[:, None] - WINDOW)
                 & (wpos[None, :] >= 0))
        sw = jnp.einsum('bqghd,bkgd->bghqk', qrb, kwb).astype(jnp.float32) * scale
        pw = masked_softmax(sw, wmask)
        o_win = jnp.einsum('bghqk,bkgd->bqghd', pw.astype(vwb.dtype), vwb)
        return gb[..., 0:1] * o_cmp + gb[..., 1:2] * o_slc + gb[..., 2:3] * o_win

    return unblock(lax.map(block, jnp.arange(S // Q_BLOCK)))


def setup_inputs(seed: int = 0) -> dict:
    key = jax.random.key(seed)
    ks = jax.random.split(key, 20)

    def nrm(k, shape, scale):
        return jax.random.normal(k, shape, jnp.float32) * scale

    L, D = DEPTH, D_MODEL
    return {
        "x": nrm(ks[0], (BATCH, SEQ, D), 1.0),
        "p": nrm(ks[1], (DEPTH, BATCH, SEQ, PLE_DIM), 1.0),
        "positions": jnp.broadcast_to(jnp.arange(SEQ, dtype=jnp.int32)[None, :], (BATCH, SEQ)),
        "norm_g": 1.0 + nrm(ks[2], (L, D), 0.02),
        "w_in": nrm(ks[3], (L, D, N_IN), D ** -0.5),
        "diff_lambda": nrm(ks[4], (L, 4, HEAD_DIM), 0.1),
        "diff_subln_g": 1.0 + nrm(ks[5], (L, DA_VDIM), 0.02),
        "cmp_pe_k": nrm(ks[6], (L, CMP_LEN, HEAD_DIM), 0.1),
        "cmp_w1_k": nrm(ks[7], (L, CMP_LEN, HEAD_DIM, CMP_HIDDEN), (CMP_LEN * HEAD_DIM) ** -0.5),
        "cmp_w2_k": nrm(ks[8], (L, CMP_HIDDEN, HEAD_DIM), CMP_HIDDEN ** -0.5),
        "cmp_pe_v": nrm(ks[9], (L, CMP_LEN, HEAD_DIM), 0.1),
        "cmp_w1_v": nrm(ks[10], (L, CMP_LEN, HEAD_DIM, CMP_HIDDEN), (CMP_LEN * HEAD_DIM) ** -0.5),
        "cmp_w2_v": nrm(ks[11], (L, CMP_HIDDEN, HEAD_DIM), CMP_HIDDEN ** -0.5),
        "w_up": nrm(ks[12], (L, N_BRANCH, BRANCH_WIDTH, D), BRANCH_WIDTH ** -0.5),
        "w_out": nrm(ks[13], (L, D, D), D ** -0.5),
        "ple_norm_g": 1.0 + nrm(ks[14], (L, D), 0.02),
        "w_ple": nrm(ks[15], (L, PLE_DIM, D), PLE_DIM ** -0.5),
        "w_ple_gate": nrm(ks[16], (L, D, D), D ** -0.5),
        "final_norm_g": 1.0 + nrm(ks[17], (D,), 0.02),
    }


def reference(x, p, positions, norm_g, w_in, diff_lambda, diff_subln_g,
              cmp_pe_k, cmp_w1_k, cmp_w2_k, cmp_pe_v, cmp_w1_v, cmp_w2_v,
              w_up, w_out, ple_norm_g, w_ple, w_ple_gate, final_norm_g):
    B, S, D = x.shape
    k_sel = min(DSA_TOPK_MAX, S // 4)
    n_sel = min(SLC_TOPN_MAX, S // SLC_BLOCK)
    cos, sin = rope_tables(positions)
    offsets = np.cumsum(IN_SPLITS)[:-1].tolist()
    for i in range(DEPTH):
        h = rmsnorm(x, norm_g[i])
        z = h @ w_in[i]
        (a_q, a_k, a_v, a_g, b_q, b_k, b_v, b_g, i_q, i_k, i_w,
         c_q, c_kc, c_vc, c_ks, c_vs, c_kw, c_vw, c_g, c_bg, merge) = jnp.split(z, offsets, axis=-1)

        lam_init = 0.8 - 0.6 * math.exp(-0.3 * i)
        lp = diff_lambda[i].astype(jnp.float32)
        lam = jnp.exp(jnp.sum(lp[0] * lp[1])) - jnp.exp(jnp.sum(lp[2] * lp[3])) + lam_init
        qa = apply_rope(a_q.reshape(B, S, DA_HEADS, 2, HEAD_DIM), cos, sin)
        ka = apply_rope(a_k.reshape(B, S, DA_HEADS, 2, HEAD_DIM), cos, sin)
        o_a = diff_attention(qa, ka, a_v.reshape(B, S, DA_HEADS, DA_VDIM), lam, diff_subln_g[i], lam_init)

        o_b = dsa_attention(apply_rope(b_q.reshape(B, S, DSA_HEADS, HEAD_DIM), cos, sin),
                            apply_rope(b_k, cos, sin), b_v,
                            apply_rope(i_q.reshape(B, S, IDX_HEADS, IDX_DIM), cos, sin),
                            apply_rope(i_k, cos, sin), i_w, k_sel)

        grp = (B, S, NSA_GROUPS, HEAD_DIM)
        qc = c_q.reshape(B, S, NSA_GROUPS, NSA_HPG, HEAD_DIM)
        kc = compress(c_kc.reshape(grp), cmp_pe_k[i], cmp_w1_k[i], cmp_w2_k[i])
        vc = compress(c_vc.reshape(grp), cmp_pe_v[i], cmp_w1_v[i], cmp_w2_v[i])
        o_c = nsa_attention(qc, apply_rope(qc, cos, sin), kc, vc,
                            apply_rope(c_ks.reshape(grp), cos, sin), c_vs.reshape(grp),
                            apply_rope(c_kw.reshape(grp), cos, sin), c_vw.reshape(grp),
                            c_bg.reshape(B, S, NSA_GROUPS, NSA_HPG, 3), n_sel)

        branches = jnp.stack([o_a * jax.nn.silu(a_g), o_b * jax.nn.silu(b_g),
                              o_c * jax.nn.silu(c_g)], axis=2)
        up = jnp.einsum('bsnw,nwd->bsnd', branches, w_up[i])
        gates = jax.nn.sigmoid(merge.reshape(B, S, N_BRANCH, D))
        x = x + jnp.sum(gates * up, axis=2) @ w_out[i]

        x = x + (p[i] @ w_ple[i]) * jax.nn.sigmoid(rmsnorm(x, ple_norm_g[i]) @ w_ple_gate[i])
    return rmsnorm(x, final_norm_g)
```

```cpp
#include <hip/hip_runtime.h>
#include <hip/hip_cooperative_groups.h>
#include <cstdio>
#include <cmath>
namespace cg = cooperative_groups;

#define DI __device__ __forceinline__
typedef unsigned short u16;
typedef unsigned char u8;
typedef unsigned long long u64;
typedef __attribute__((ext_vector_type(8))) short bf16x8;
typedef __attribute__((ext_vector_type(4))) short s16x4;
typedef __attribute__((ext_vector_type(16))) float f32x16;
typedef __attribute__((ext_vector_type(2))) float f32x2;
typedef __attribute__((ext_vector_type(2))) __bf16 bf16x2v;
typedef __attribute__((ext_vector_type(4))) unsigned u32x4;
typedef __attribute__((ext_vector_type(2))) unsigned u32x2;
typedef __attribute__((ext_vector_type(4))) float f32x4;
#define MFMA32(a, b, c) __builtin_amdgcn_mfma_f32_32x32x16_bf16((a), (b), (c), 0, 0, 0)

constexpr int NB = 4, S = 4096, T = NB * S, D = 1024, NL = 2, NIN = 8672, PLE = 256;
constexpr int OW = 1536;

constexpr size_t WS_W1 = 0;
constexpr size_t WS_WG = WS_W1 + (size_t)4096 * 1024 * 2;
constexpr size_t WS_WM = WS_WG + (size_t)1536 * 1024 * 2;
constexpr size_t WS_WUP = WS_WM + (size_t)3072 * 1024 * 2;
constexpr size_t WS_WOUT = WS_WUP + (size_t)3 * 1024 * 512 * 2;
constexpr size_t WS_WPLE = WS_WOUT + (size_t)1024 * 1024 * 2;
constexpr size_t WS_WPG = WS_WPLE + (size_t)1024 * 256 * 2;
constexpr size_t WS_CW1 = WS_WPG + (size_t)1024 * 1024 * 2;
constexpr size_t WS_CW2 = WS_CW1 + (size_t)2 * 128 * 2048 * 2;
constexpr size_t WS_COS = WS_CW2 + (size_t)2 * 64 * 128 * 2;
constexpr size_t WS_SIN = WS_COS + (size_t)T * 8 * 4;
constexpr size_t WS_CTR = WS_SIN + (size_t)T * 8 * 4;
constexpr size_t WS_XB = WS_CTR + 256;
constexpr size_t WS_RINV = WS_XB + (size_t)T * 1024 * 2;
constexpr size_t WS_AQ = WS_RINV + (size_t)T * 4;
constexpr size_t WS_AK = WS_AQ + (size_t)T * 512 * 2;
constexpr size_t WS_AVT = WS_AK + (size_t)T * 512 * 2;
constexpr size_t WS_BQ = WS_AVT + (size_t)T * 512 * 2;
constexpr size_t WS_BK = WS_BQ + (size_t)T * 512 * 2;
constexpr size_t WS_BV = WS_BK + (size_t)T * 64 * 2;
constexpr size_t WS_IQ = WS_BV + (size_t)T * 64 * 2;
constexpr size_t WS_IK = WS_IQ + (size_t)T * 512 * 2;
constexpr size_t WS_MISC = WS_IK + (size_t)T * 64 * 2;
constexpr size_t WS_CQ = WS_MISC + (size_t)T * 32 * 4;
constexpr size_t WS_CKC = WS_CQ + (size_t)T * 512 * 2;
constexpr size_t WS_CVC = WS_CKC + (size_t)T * 128 * 2;
constexpr size_t WS_CKS = WS_CVC + (size_t)T * 128 * 2;
constexpr size_t WS_CVST = WS_CKS + (size_t)T * 128 * 2;
constexpr size_t WS_CKW = WS_CVST + (size_t)T * 128 * 2;
constexpr size_t WS_CVWT = WS_CKW + (size_t)T * 128 * 2;
constexpr size_t WS_KC = WS_CVWT + (size_t)T * 128 * 2;
constexpr size_t WS_VCT = WS_KC + (size_t)NB * 2 * 256 * 64 * 2;
constexpr size_t WS_O = WS_VCT + (size_t)NB * 2 * 64 * 256 * 2;
constexpr size_t WS_PART0 = WS_O + (size_t)T * OW * 2;
constexpr size_t WS_PART1 = WS_PART0 + (size_t)T * 16 * 4;
constexpr size_t WS_BAR = WS_PART1 + (size_t)T * 16 * 4;
constexpr size_t WS_END = WS_BAR + 16384;
constexpr size_t WS_XB1 = WS_CQ;
static_assert(WS_XB1 + (size_t)T * 1024 * 2 <= WS_CKW, "xb1 alias overflows");
constexpr size_t WS_MIXED = WS_AQ;
constexpr size_t WS_PB = WS_BQ;
constexpr size_t WS_MG = WS_AVT;
static_assert(WS_MG + (size_t)T * 3072 * 2 <= WS_KC, "merge-gate alias overflows");

struct Params {
  const float *x, *p;
  const int* pos;
  const float *norm_g, *w_in, *dlam, *dsub, *pe_k, *w1_k, *w2_k, *pe_v, *w1_v, *w2_v, *w_up, *w_out, *ple_g, *w_ple, *w_pg, *fin_g;
  float* out;
  u8* ws;
  float inv[8];
};

DI unsigned pack2(float a, float b) { f32x2 v = {a, b}; return __builtin_bit_cast(unsigned, __builtin_convertvector(v, bf16x2v)); }
DI u16 f2bf(float a) { return (u16)(pack2(a, 0.f) & 0xffffu); }
DI float bf2f(u16 v) { return __uint_as_float(((unsigned)v) << 16); }
DI float bflo(unsigned v) { return __uint_as_float(v << 16); }
DI float bfhi(unsigned v) { return __uint_as_float(v & 0xffff0000u); }
DI int otid() { int t = threadIdx.x; asm volatile("" : "+v"(t)); return t; }
DI int crow(int r, int h) { return (r & 3) + 8 * (r >> 2) + 4 * h; }
DI float wsum(float v) { for (int o = 32; o; o >>= 1) v += __shfl_xor(v, o); return v; }
DI float wmaxf(float v) { for (int o = 32; o; o >>= 1) v = fmaxf(v, __shfl_xor(v, o)); return v; }
DI int wsum_dpp(int v) {
  v += __builtin_amdgcn_update_dpp(0, v, 0x111, 0xf, 0xf, true);
  v += __builtin_amdgcn_update_dpp(0, v, 0x112, 0xf, 0xf, true);
  v += __builtin_amdgcn_update_dpp(0, v, 0x114, 0xf, 0xf, true);
  v += __builtin_amdgcn_update_dpp(0, v, 0x118, 0xf, 0xf, true);
  v += __builtin_amdgcn_update_dpp(0, v, 0x142, 0xa, 0xf, true);
  v += __builtin_amdgcn_update_dpp(0, v, 0x143, 0xc, 0xf, true);
  return __builtin_amdgcn_readlane(v, 63);
}
DI int wscan_dpp(int v) {
  v += __builtin_amdgcn_update_dpp(0, v, 0x111, 0xf, 0xf, true);
  v += __builtin_amdgcn_update_dpp(0, v, 0x112, 0xf, 0xf, true);
  v += __builtin_amdgcn_update_dpp(0, v, 0x114, 0xf, 0xf, true);
  v += __builtin_amdgcn_update_dpp(0, v, 0x118, 0xf, 0xf, true);
  v += __builtin_amdgcn_update_dpp(0, v, 0x142, 0xa, 0xf, true);
  v += __builtin_amdgcn_update_dpp(0, v, 0x143, 0xc, 0xf, true);
  return v;
}
DI float ex2(float x) { return __builtin_amdgcn_exp2f(x); }
DI float sigm(float x) { return __builtin_amdgcn_rcpf(1.f + __expf(-x)); }
DI int mbcnt(u64 m) { return __builtin_amdgcn_mbcnt_hi((unsigned)(m >> 32), __builtin_amdgcn_mbcnt_lo((unsigned)m, 0)); }

DI float rinv_of(const float* part, int tok) {
  const f32x4* q = (const f32x4*)(part + (size_t)tok * 16);
  const f32x4 a = q[0], b = q[1], c = q[2], d = q[3];
  const float ss = ((a.x + a.y) + (a.z + a.w)) + ((b.x + b.y) + (b.z + b.w)) + (((c.x + c.y) + (c.z + c.w)) + ((d.x + d.y) + (d.z + d.w)));
  return rsqrtf(ss * (1.f / 1024.f) + 1e-6f);
}
constexpr float SCL2 = 0.125f * 1.4426950408889634f;
constexpr float MASKV = -3.0e38f, MINIT = -1.0e30f;

struct TJob { const float* src; u16* dst; const float* scale; int ld, K, N, map; };

DI TJob get_job(const Params& p, int l, int j) {
  TJob t; t.scale = nullptr; t.map = 0; t.src = nullptr; t.dst = nullptr; t.ld = 0; t.K = 0; t.N = 0;
  u8* ws = p.ws;
  if (j == 0) { t.src = p.w_in + (size_t)l * D * NIN; t.dst = (u16*)(ws + WS_W1); t.scale = p.norm_g + l * D; t.ld = NIN; t.K = 1024; t.N = 4096; t.map = 1; }
  else if (j == 1) { t.src = p.w_in + (size_t)l * D * NIN; t.dst = (u16*)(ws + WS_WG); t.scale = p.norm_g + l * D; t.ld = NIN; t.K = 1024; t.N = 1536; t.map = 2; }
  else if (j == 2) { t.src = p.w_in + (size_t)l * D * NIN; t.dst = (u16*)(ws + WS_WM); t.scale = p.norm_g + l * D; t.ld = NIN; t.K = 1024; t.N = 3072; t.map = 3; }
  else if (j <= 5) { int n = j - 3; t.src = p.w_up + (size_t)(l * 3 + n) * 512 * 1024; t.dst = (u16*)(ws + WS_WUP) + (size_t)n * 1024 * 512; t.ld = 1024; t.K = 512; t.N = 1024; }
  else if (j == 6) { t.src = p.w_out + (size_t)l * D * D; t.dst = (u16*)(ws + WS_WOUT); t.ld = 1024; t.K = 1024; t.N = 1024; }
  else if (j == 7) { t.src = p.w_ple + (size_t)l * PLE * D; t.dst = (u16*)(ws + WS_WPLE); t.ld = 1024; t.K = 256; t.N = 1024; }
  else if (j == 8) { t.src = p.w_pg + (size_t)l * D * D; t.dst = (u16*)(ws + WS_WPG); t.scale = p.ple_g + l * D; t.ld = 1024; t.K = 1024; t.N = 1024; }
  else if (j == 9) { t.src = p.w1_k + (size_t)l * 2048 * 128; t.dst = (u16*)(ws + WS_CW1); t.ld = 128; t.K = 2048; t.N = 128; }
  else if (j == 10) { t.src = p.w1_v + (size_t)l * 2048 * 128; t.dst = (u16*)(ws + WS_CW1) + 128 * 2048; t.ld = 128; t.K = 2048; t.N = 128; }
  else if (j == 11) { t.src = p.w2_k + (size_t)l * 128 * 64; t.dst = (u16*)(ws + WS_CW2); t.ld = 64; t.K = 128; t.N = 64; }
  else { t.src = p.w2_v + (size_t)l * 128 * 64; t.dst = (u16*)(ws + WS_CW2) + 64 * 128; t.ld = 64; t.K = 128; t.N = 64; }
  return t;
}
constexpr int NJOBS = 13;

DI int srccol(int map, int n) {
  if (map == 0) return n;
  if (map == 1) {
    if (n < 1536) return n;
    if (n < 2176) return n + 512;
    if (n < 2760) return n + 1024;
    if (n < 2784) return n + 2816;
    if (n < 2816) return -1;
    return n + 968;
  }
  if (map == 2) { if (n < 512) return n + 1536; if (n < 1024) return n + 2176; return n + 4040; }
  return n + 5600;
}

DI void prep_tile(const TJob& j, int tile, float* sm) {
  const int ktiles = j.K >> 6;
  const int nt = tile / ktiles, kt = tile - nt * ktiles;
  const int n0 = nt * 64, k0 = kt * 64;
  const int tid_ = otid();
  const int tx = tid_ & 63, ty = tid_ >> 6;
  const int sc = srccol(j.map, n0 + tx);
  float v[16];
#pragma unroll
  for (int i = 0; i < 16; i++) {
    const int k = ty + 4 * i;
    v[i] = (sc >= 0) ? j.src[(size_t)(k0 + k) * j.ld + sc] : 0.f;
  }
  if (j.scale) {
#pragma unroll
    for (int i = 0; i < 16; i++) v[i] *= j.scale[k0 + ty + 4 * i];
  }
  __syncthreads();
#pragma unroll
  for (int i = 0; i < 16; i++) sm[(ty + 4 * i) * 65 + tx] = v[i];
  __syncthreads();
  const int kc = (tid_ & 7) * 8;
#pragma unroll
  for (int pass = 0; pass < 2; pass++) {
    const int n = (tid_ >> 3) + 32 * pass;
    u32x4 o;
    o.x = pack2(sm[(kc + 0) * 65 + n], sm[(kc + 1) * 65 + n]);
    o.y = pack2(sm[(kc + 2) * 65 + n], sm[(kc + 3) * 65 + n]);
    o.z = pack2(sm[(kc + 4) * 65 + n], sm[(kc + 5) * 65 + n]);
    o.w = pack2(sm[(kc + 6) * 65 + n], sm[(kc + 7) * 65 + n]);
    *(u32x4*)(j.dst + (size_t)(n0 + n) * j.K + k0 + kc) = o;
  }
}

DI void prep_layer(const Params& p, int l, u8* smem) {
  int total = 0;
  for (int j = 0; j < NJOBS; j++) { TJob t = get_job(p, l, j); total += (t.N >> 6) * (t.K >> 6); }
  for (int tile = blockIdx.x; tile < total; tile += gridDim.x) {
    int j = 0, tt = tile;
    TJob t = get_job(p, l, 0);
    for (;;) { int n = (t.N >> 6) * (t.K >> 6); if (tt < n) break; tt -= n; j++; t = get_job(p, l, j); }
    prep_tile(t, tt, (float*)smem);
  }
}

DI void rope_tables(const Params& p) {
  float* cosT = (float*)(p.ws + WS_COS); float* sinT = (float*)(p.ws + WS_SIN);
  for (int i = blockIdx.x * 256 + otid(); i < T * 8; i += gridDim.x * 256) {
    int t = i >> 3, j = i & 7;
    float ang = (float)p.pos[t] * p.inv[j];
    double rev = (double)ang * 0.15915494309189535;
    rev -= floor(rev);
    if (rev >= 0.5) rev -= 1.0;
    float a = (float)(rev * 6.283185307179586);
    cosT[i] = cosf(a); sinT[i] = sinf(a);
  }
}

DI void norm_rows(const float* src, u16* xb, float* rinv) {
  const int tid_ = otid();
  const int wv = __builtin_amdgcn_readfirstlane(tid_ >> 6), lane = tid_ & 63;
  for (int row = blockIdx.x * 4 + wv; row < T; row += gridDim.x * 4) {
    const f32x4* s4 = (const f32x4*)(src + (size_t)row * D);
    f32x4 v[4]; float ss = 0.f;
#pragma unroll
    for (int i = 0; i < 4; i++) { v[i] = s4[lane + 64 * i]; ss += v[i].x * v[i].x + v[i].y * v[i].y + v[i].z * v[i].z + v[i].w * v[i].w; }
    ss = wsum(ss);
    if (lane < 16) rinv[(size_t)row * 16 + lane] = (lane == 0) ? ss : 0.f;
#pragma unroll
    for (int i = 0; i < 4; i++) { u32x2 o; o.x = pack2(v[i].x, v[i].y); o.y = pack2(v[i].z, v[i].w); ((u32x2*)(xb + (size_t)row * D))[lane + 64 * i] = o; }
  }
}
DI void final_norm(float* xo, const float* g, const float* part) {
  const int tid_ = otid();
  const int wv = __builtin_amdgcn_readfirstlane(tid_ >> 6), lane = tid_ & 63;
  for (int row = blockIdx.x * 4 + wv; row < T; row += gridDim.x * 4) {
    f32x4* s4 = (f32x4*)(xo + (size_t)row * D);
    const f32x4* g4 = (const f32x4*)g;
    const float r = rinv_of(part, row);
#pragma unroll
    for (int i = 0; i < 4; i++) { f32x4 v = s4[lane + 64 * i]; f32x4 gg = g4[lane + 64 * i]; f32x4 o; o.x = v.x * r * gg.x; o.y = v.y * r * gg.y; o.z = v.z * r * gg.z; o.w = v.w * r * gg.w; s4[lane + 64 * i] = o; }
  }
}
DI void convert_p(const float* src, u16* dst) {
  const int n4 = T * PLE / 4;
  for (int i = blockIdx.x * 256 + otid(); i < n4; i += gridDim.x * 256) {
    f32x4 v = ((const f32x4*)src)[i]; u32x2 o; o.x = pack2(v.x, v.y); o.y = pack2(v.z, v.w); ((u32x2*)dst)[i] = o;
  }
}

constexpr int GS = 72;
DI void gemm_compute_ktile(f32x16 (&acc)[2][2], const u16* sA, const u16* sB, int wm, int wn, int lr, int h) {
  const u16* pa = &sA[(wm * 64 + lr) * GS + h * 8];
  const u16* pb = &sB[(wn * 64 + lr) * GS + h * 8];
  bf16x8 fa[2][2], fb[2][2];
  fa[0][0] = *(const bf16x8*)(pa); fa[0][1] = *(const bf16x8*)(pa + 32 * GS);
  fb[0][0] = *(const bf16x8*)(pb); fb[0][1] = *(const bf16x8*)(pb + 32 * GS);
#pragma unroll
  for (int s = 0; s < 4; s++) {
    const int cur = s & 1, nxt = cur ^ 1;
    if (s < 3) {
      fa[nxt][0] = *(const bf16x8*)(pa + (s + 1) * 16); fa[nxt][1] = *(const bf16x8*)(pa + 32 * GS + (s + 1) * 16);
      fb[nxt][0] = *(const bf16x8*)(pb + (s + 1) * 16); fb[nxt][1] = *(const bf16x8*)(pb + 32 * GS + (s + 1) * 16);
    }
    __builtin_amdgcn_sched_barrier(0);
    acc[0][0] = MFMA32(fa[cur][0], fb[cur][0], acc[0][0]); acc[0][1] = MFMA32(fa[cur][0], fb[cur][1], acc[0][1]);
    acc[1][0] = MFMA32(fa[cur][1], fb[cur][0], acc[1][0]); acc[1][1] = MFMA32(fa[cur][1], fb[cur][1], acc[1][1]);
    __builtin_amdgcn_sched_barrier(0);
  }
}
DI void gemm_tile(f32x16 (&acc)[2][2], const u16* __restrict__ A, int lda, const u16* __restrict__ Bt, int ldb, int K, u16* sA, u16* sB, int kst = 0) {
  const int tid = otid(), lane = tid & 63, w = __builtin_amdgcn_readfirstlane(tid >> 6), lr = lane & 31, h = lane >> 5;
  const int wm = w >> 1, wn = w & 1;
  const int lrow = tid >> 3, lkc = (tid & 7) * 8;
  u32x4 ra0[4], rb0[4], ra1[4], rb1[4];
  const char* ap = (const char*)A; const char* bp = (const char*)Bt;
  const unsigned aoff = (unsigned)((lrow * lda + lkc) * 2), boff = (unsigned)((lrow * ldb + lkc) * 2);
  const int km = K - 1;
  {
    const int ka = kst & km, kb = (kst + 64) & km;
#pragma unroll
    for (int i = 0; i < 4; i++) { ra0[i] = *(const u32x4*)(ap + ((size_t)(32 * i) * lda + ka) * 2 + aoff); rb0[i] = *(const u32x4*)(bp + ((size_t)(32 * i) * ldb + ka) * 2 + boff); }
#pragma unroll
    for (int i = 0; i < 4; i++) { ra1[i] = *(const u32x4*)(ap + ((size_t)(32 * i) * lda + kb) * 2 + aoff); rb1[i] = *(const u32x4*)(bp + ((size_t)(32 * i) * ldb + kb) * 2 + boff); }
  }
  for (int k0 = 0; k0 < K; k0 += 128) {
    __syncthreads();
#pragma unroll
    for (int i = 0; i < 4; i++) { *(u32x4*)&sA[(lrow + 32 * i) * GS + lkc] = ra0[i]; *(u32x4*)&sB[(lrow + 32 * i) * GS + lkc] = rb0[i]; }
    __syncthreads();
    if (k0 + 128 < K) {
      const int kk = (kst + k0 + 128) & km;
#pragma unroll
      for (int i = 0; i < 4; i++) { ra0[i] = *(const u32x4*)(ap + ((size_t)(32 * i) * lda + kk) * 2 + aoff); rb0[i] = *(const u32x4*)(bp + ((size_t)(32 * i) * ldb + kk) * 2 + boff); }
    }
    gemm_compute_ktile(acc, sA, sB, wm, wn, lr, h);
    __syncthreads();
#pragma unroll
    for (int i = 0; i < 4; i++) { *(u32x4*)&sA[(lrow + 32 * i) * GS + lkc] = ra1[i]; *(u32x4*)&sB[(lrow + 32 * i) * GS + lkc] = rb1[i]; }
    __syncthreads();
    if (k0 + 192 < K) {
      const int kk = (kst + k0 + 192) & km;
#pragma unroll
      for (int i = 0; i < 4; i++) { ra1[i] = *(const u32x4*)(ap + ((size_t)(32 * i) * lda + kk) * 2 + aoff); rb1[i] = *(const u32x4*)(bp + ((size_t)(32 * i) * ldb + kk) * 2 + boff); }
    }
    gemm_compute_ktile(acc, sA, sB, wm, wn, lr, h);
  }
}
DI void gemm_tile1(f32x16 (&acc)[2][2], const u16* __restrict__ A, int lda, const u16* __restrict__ Bt, int ldb, int K, u16* sA, u16* sB, int kst = 0) {
  const int tid = otid(), lane = tid & 63, w = __builtin_amdgcn_readfirstlane(tid >> 6), lr = lane & 31, h = lane >> 5;
  const int wm = w >> 1, wn = w & 1;
  const int lrow = tid >> 3, lkc = (tid & 7) * 8;
  u32x4 ra[4], rb[4];
  const char* ap = (const char*)A; const char* bp = (const char*)Bt;
  const unsigned aoff = (unsigned)((lrow * lda + lkc) * 2), boff = (unsigned)((lrow * ldb + lkc) * 2);
  const int km = K - 1;
  {
    const int ka = kst & km;
#pragma unroll
    for (int i = 0; i < 4; i++) { ra[i] = *(const u32x4*)(ap + ((size_t)(32 * i) * lda + ka) * 2 + aoff); rb[i] = *(const u32x4*)(bp + ((size_t)(32 * i) * ldb + ka) * 2 + boff); }
  }
  for (int k0 = 0; k0 < K; k0 += 64) {
    __syncthreads();
#pragma unroll
    for (int i = 0; i < 4; i++) { *(u32x4*)&sA[(lrow + 32 * i) * GS + lkc] = ra[i]; *(u32x4*)&sB[(lrow + 32 * i) * GS + lkc] = rb[i]; }
    __syncthreads();
    if (k0 + 64 < K) {
      const int kk = (kst + k0 + 64) & km;
#pragma unroll
      for (int i = 0; i < 4; i++) { ra[i] = *(const u32x4*)(ap + ((size_t)(32 * i) * lda + kk) * 2 + aoff); rb[i] = *(const u32x4*)(bp + ((size_t)(32 * i) * ldb + kk) * 2 + boff); }
    }
    gemm_compute_ktile(acc, sA, sB, wm, wn, lr, h);
  }
}
DI void gemm_tile_w(f32x16 (&acc)[2][4], const u16* __restrict__ A, int lda, const u16* __restrict__ Bt, int ldb, int K, u16* sA, u16* sB, int kst) {
  const int tid = otid(), lane = tid & 63, w = __builtin_amdgcn_readfirstlane(tid >> 6), lr = lane & 31, h = lane >> 5;
  const int wm = w >> 1, wn = w & 1;
  const int lrow = tid >> 3, lkc = (tid & 7) * 8;
  u32x4 ra[4], rb[8];
  const char* ap = (const char*)A; const char* bp = (const char*)Bt;
  const unsigned aoff = (unsigned)((lrow * lda + lkc) * 2), boff = (unsigned)((lrow * ldb + lkc) * 2);
  const int km = K - 1;
  {
    const int ka = kst & km;
#pragma unroll
    for (int i = 0; i < 4; i++) ra[i] = *(const u32x4*)(ap + ((size_t)(32 * i) * lda + ka) * 2 + aoff);
#pragma unroll
    for (int i = 0; i < 8; i++) rb[i] = *(const u32x4*)(bp + ((size_t)(32 * i) * ldb + ka) * 2 + boff);
  }
  for (int k0 = 0; k0 < K; k0 += 64) {
    __syncthreads();
#pragma unroll
    for (int i = 0; i < 4; i++) *(u32x4*)&sA[(lrow + 32 * i) * GS + lkc] = ra[i];
#pragma unroll
    for (int i = 0; i < 8; i++) *(u32x4*)&sB[(lrow + 32 * i) * GS + lkc] = rb[i];
    __syncthreads();
    if (k0 + 64 < K) {
      const int kk = (kst + k0 + 64) & km;
#pragma unroll
      for (int i = 0; i < 4; i++) ra[i] = *(const u32x4*)(ap + ((size_t)(32 * i) * lda + kk) * 2 + aoff);
#pragma unroll
      for (int i = 0; i < 8; i++) rb[i] = *(const u32x4*)(bp + ((size_t)(32 * i) * ldb + kk) * 2 + boff);
    }
    const u16* pa = &sA[(wm * 64 + lr) * GS + h * 8];
    const u16* pb = &sB[(wn * 128 + lr) * GS + h * 8];
#pragma unroll
    for (int s = 0; s < 4; s++) {
      bf16x8 fa[2], fb[4];
      fa[0] = *(const bf16x8*)(pa + s * 16); fa[1] = *(const bf16x8*)(pa + 32 * GS + s * 16);
#pragma unroll
      for (int ni = 0; ni < 4; ni++) fb[ni] = *(const bf16x8*)(pb + ni * 32 * GS + s * 16);
#pragma unroll
      for (int ni = 0; ni < 4; ni++) { acc[0][ni] = MFMA32(fa[0], fb[ni], acc[0][ni]); acc[1][ni] = MFMA32(fa[1], fb[ni], acc[1][ni]); }
    }
  }
}
DI void zero_acc_w(f32x16 (&acc)[2][4]) {
#pragma unroll
  for (int a = 0; a < 2; a++)
#pragma unroll
    for (int b = 0; b < 4; b++)
#pragma unroll
      for (int r = 0; r < 16; r++) acc[a][b][r] = 0.f;
}
DI void zero_acc(f32x16 (&acc)[2][2]) {
#pragma unroll
  for (int a = 0; a < 2; a++)
#pragma unroll
    for (int b = 0; b < 2; b++)
#pragma unroll
      for (int r = 0; r < 16; r++) acc[a][b][r] = 0.f;
}

DI void p1_store_sw(const Params& p, const f32x16& acc, int fb, int tokbase, int lr, int h) {
  u8* ws = p.ws;
  const float* part = (const float*)(ws + WS_PART0);
  int kind = 0, ld = 512, c = 0; bool rope = false; u16* dst = nullptr;
  if (fb < 512) { dst = (u16*)(ws + WS_AQ); c = fb; rope = true; }
  else if (fb < 1024) { dst = (u16*)(ws + WS_AK); c = fb - 512; rope = true; }
  else if (fb < 1536) { kind = 1; dst = (u16*)(ws + WS_AVT); c = fb - 1024; }
  else if (fb < 2048) { dst = (u16*)(ws + WS_BQ); c = fb - 1536; rope = true; }
  else if (fb < 2112) { dst = (u16*)(ws + WS_BK); ld = 64; c = fb - 2048; rope = true; }
  else if (fb < 2176) { dst = (u16*)(ws + WS_BV); ld = 64; c = fb - 2112; }
  else if (fb < 2688) { dst = (u16*)(ws + WS_IQ); c = fb - 2176; rope = true; }
  else if (fb < 2752) { dst = (u16*)(ws + WS_IK); ld = 64; c = fb - 2688; rope = true; }
  else if (fb < 2784) { kind = 2; }
  else if (fb < 2816) { kind = 3; }
  else if (fb < 3328) { dst = (u16*)(ws + WS_CQ); c = fb - 2816; }
  else if (fb < 3456) { dst = (u16*)(ws + WS_CKC); ld = 128; c = fb - 3328; }
  else if (fb < 3584) { dst = (u16*)(ws + WS_CVC); ld = 128; c = fb - 3456; }
  else if (fb < 3712) { dst = (u16*)(ws + WS_CKS); ld = 128; c = fb - 3584; rope = true; }
  else if (fb < 3840) { kind = 1; dst = (u16*)(ws + WS_CVST); c = fb - 3712; }
  else if (fb < 3968) { dst = (u16*)(ws + WS_CKW); ld = 128; c = fb - 3840; rope = true; }
  else { kind = 1; dst = (u16*)(ws + WS_CVWT); c = fb - 3968; }
  if (kind == 3) return;
  rope = rope && ((fb & 32) == 0);
  const int tok = tokbase + lr;
  const float rv = rinv_of(part, tok);
  float v[16];
#pragma unroll
  for (int r = 0; r < 16; r++) v[r] = acc[r] * rv;
  if (rope) {
    const f32x4 cs = *(const f32x4*)((const float*)(ws + WS_COS) + (size_t)tok * 8 + 4 * h);
    const f32x4 sn = *(const f32x4*)((const float*)(ws + WS_SIN) + (size_t)tok * 8 + 4 * h);
#pragma unroll
    for (int j = 0; j < 4; j++) {
      const float x1 = v[j], x2 = v[4 + j];
      v[j] = x1 * cs[j] - x2 * sn[j];
      v[4 + j] = x2 * cs[j] + x1 * sn[j];
    }
  }
  if (kind == 0) {
#pragma unroll
    for (int g = 0; g < 4; g++) {
      u32x2 o; o.x = pack2(v[4 * g], v[4 * g + 1]); o.y = pack2(v[4 * g + 2], v[4 * g + 3]);
      *(u32x2*)(dst + (size_t)tok * ld + c + 8 * g + 4 * h) = o;
    }
  } else if (kind == 1) {
#pragma unroll
    for (int r = 0; r < 16; r++) dst[(size_t)(c + crow(r, h)) * T + tok] = f2bf(v[r]);
  } else {
    float* m = (float*)(ws + WS_MISC);
#pragma unroll
    for (int g = 0; g < 4; g++) {
      f32x4 o; o.x = v[4 * g]; o.y = v[4 * g + 1]; o.z = v[4 * g + 2]; o.w = v[4 * g + 3];
      *(f32x4*)(m + (size_t)tok * 32 + 8 * g + 4 * h) = o;
    }
  }
}

DI void phase_gemm1(const Params& p, u8* smem) {
  u16* sA = (u16*)smem; u16* sB = sA + 128 * GS;
  const u16* xb = (const u16*)(p.ws + WS_XB);
  const u16* W = (const u16*)(p.ws + WS_W1);
  const int tid_ = otid();
  const int lane = tid_ & 63, w = __builtin_amdgcn_readfirstlane(tid_ >> 6), lr = lane & 31, h = lane >> 5, wm = w >> 1, wn = w & 1;
  for (int tile = blockIdx.x; tile < 32 * 64; tile += gridDim.x) {
    const int ft = tile & 31, tt = tile >> 5;
    f32x16 acc[2][4]; zero_acc_w(acc);
    gemm_tile_w(acc, W + (size_t)ft * 128 * D, D, xb + (size_t)tt * 256 * D, D, D, sA, sB, (ft >> 3) * 256);
#pragma unroll
    for (int mi = 0; mi < 2; mi++)
#pragma unroll
      for (int ni = 0; ni < 4; ni++)
        p1_store_sw(p, acc[mi][ni], ft * 128 + wm * 64 + mi * 32, tt * 256 + wn * 128 + ni * 32, lr, h);
  }
}

DI void phase_gates(const Params& p, u8* smem) {
  u16* sA = (u16*)smem; u16* sB = sA + 128 * GS;
  const u16* xb = (const u16*)(p.ws + WS_XB);
  const u16* W = (const u16*)(p.ws + WS_WG);
  const float* part = (const float*)(p.ws + WS_PART0);
  u16* O = (u16*)(p.ws + WS_O);
  u16* MG = (u16*)(p.ws + WS_MG);
  const int tid_ = otid();
  const int lane = tid_ & 63, w = __builtin_amdgcn_readfirstlane(tid_ >> 6), lr = lane & 31, h = lane >> 5, wm = w >> 1, wn = w & 1;
  for (int tile = blockIdx.x; tile < 128 * 36; tile += gridDim.x) {
    const int nt = tile % 36, mt = tile / 36;
    f32x16 acc[2][2]; zero_acc(acc);
    gemm_tile(acc, W + (size_t)nt * 128 * D, D, xb + (size_t)mt * 128 * D, D, D, sA, sB, ((nt >> 3) & 3) * 256);
#pragma unroll
    for (int mi = 0; mi < 2; mi++)
#pragma unroll
      for (int ni = 0; ni < 2; ni++) {
        const int tok = mt * 128 + wn * 64 + ni * 32 + lr;
        const float rv = rinv_of(part, tok);
#pragma unroll
        for (int r = 0; r < 16; r++) {
          const float g = acc[mi][ni][r] * rv;
          const float sg = sigm(g);
          acc[mi][ni][r] = (nt < 12) ? g * sg : sg;
        }
        if (nt < 12) {
#pragma unroll
          for (int g4 = 0; g4 < 4; g4++) {
            const int f0 = nt * 128 + wm * 64 + mi * 32 + 8 * g4 + 4 * h;
            u16* op = O + (size_t)tok * OW + f0;
            const u32x2 ov = *(const u32x2*)op;
            u32x2 nv;
            nv.x = pack2(bflo(ov.x) * acc[mi][ni][4 * g4], bfhi(ov.x) * acc[mi][ni][4 * g4 + 1]);
            nv.y = pack2(bflo(ov.y) * acc[mi][ni][4 * g4 + 2], bfhi(ov.y) * acc[mi][ni][4 * g4 + 3]);
            *(u32x2*)op = nv;
          }
        } else {
          u32x4 a, b;
          a.x = pack2(acc[mi][ni][0], acc[mi][ni][1]); a.y = pack2(acc[mi][ni][2], acc[mi][ni][3]);
          a.z = pack2(acc[mi][ni][4], acc[mi][ni][5]); a.w = pack2(acc[mi][ni][6], acc[mi][ni][7]);
          b.x = pack2(acc[mi][ni][8], acc[mi][ni][9]); b.y = pack2(acc[mi][ni][10], acc[mi][ni][11]);
          b.z = pack2(acc[mi][ni][12], acc[mi][ni][13]); b.w = pack2(acc[mi][ni][14], acc[mi][ni][15]);
          u16* dst = MG + ((((size_t)mt * 24 + (nt - 12)) * 4 + (mi * 2 + ni)) * 256 + tid_) * 16;
          *(u32x4*)dst = a; *(u32x4*)(dst + 8) = b;
        }
      }
  }
}

DI void phase_mix(const Params& p, u8* smem) {
  u16* sA = (u16*)smem; u16* sB = sA + 128 * GS;
  const u16* WU = (const u16*)(p.ws + WS_WUP);
  const u16* O = (const u16*)(p.ws + WS_O);
  const u16* MG = (const u16*)(p.ws + WS_MG);
  u16* MX = (u16*)(p.ws + WS_MIXED);
  const int tid_ = otid();
  const int lane = tid_ & 63, w = __builtin_amdgcn_readfirstlane(tid_ >> 6), lr = lane & 31, h = lane >> 5, wm = w >> 1, wn = w & 1;
  for (int tile = blockIdx.x; tile < 128 * 8; tile += gridDim.x) {
    const int nt = (tile >> 3) & 7, mt = ((tile >> 6) << 3) + (tile & 7);
    f32x16 mix[2][2]; zero_acc(mix);
#pragma unroll 1
    for (int n = 0; n < 3; n++) {
      f32x16 acc[2][2]; zero_acc(acc);
      gemm_tile1(acc, WU + (size_t)(n * 1024 + nt * 128) * 512, 512, O + (size_t)mt * 128 * OW + n * 512, OW, 512, sA, sB, nt * 64);
#pragma unroll
      for (int mi = 0; mi < 2; mi++)
#pragma unroll
        for (int ni = 0; ni < 2; ni++) {
          const u16* src = MG + ((((size_t)mt * 24 + (n * 8 + nt)) * 4 + (mi * 2 + ni)) * 256 + tid_) * 16;
          const u32x4 a = *(const u32x4*)src, b = *(const u32x4*)(src + 8);
          mix[mi][ni][0] += bflo(a.x) * acc[mi][ni][0]; mix[mi][ni][1] += bfhi(a.x) * acc[mi][ni][1];
          mix[mi][ni][2] += bflo(a.y) * acc[mi][ni][2]; mix[mi][ni][3] += bfhi(a.y) * acc[mi][ni][3];
          mix[mi][ni][4] += bflo(a.z) * acc[mi][ni][4]; mix[mi][ni][5] += bfhi(a.z) * acc[mi][ni][5];
          mix[mi][ni][6] += bflo(a.w) * acc[mi][ni][6]; mix[mi][ni][7] += bfhi(a.w) * acc[mi][ni][7];
          mix[mi][ni][8] += bflo(b.x) * acc[mi][ni][8]; mix[mi][ni][9] += bfhi(b.x) * acc[mi][ni][9];
          mix[mi][ni][10] += bflo(b.y) * acc[mi][ni][10]; mix[mi][ni][11] += bfhi(b.y) * acc[mi][ni][11];
          mix[mi][ni][12] += bflo(b.z) * acc[mi][ni][12]; mix[mi][ni][13] += bfhi(b.z) * acc[mi][ni][13];
          mix[mi][ni][14] += bflo(b.w) * acc[mi][ni][14]; mix[mi][ni][15] += bfhi(b.w) * acc[mi][ni][15];
        }
    }
#pragma unroll
    for (int mi = 0; mi < 2; mi++)
#pragma unroll
      for (int ni = 0; ni < 2; ni++) {
        const int tok = mt * 128 + wn * 64 + ni * 32 + lr;
#pragma unroll
        for (int g4 = 0; g4 < 4; g4++) {
          const int f0 = nt * 128 + wm * 64 + mi * 32 + 8 * g4 + 4 * h;
          u32x2 o; o.x = pack2(mix[mi][ni][4 * g4], mix[mi][ni][4 * g4 + 1]); o.y = pack2(mix[mi][ni][4 * g4 + 2], mix[mi][ni][4 * g4 + 3]);
          *(u32x2*)(MX + (size_t)tok * D + f0) = o;
        }
      }
  }
}

DI void phase_outproj(const Params& p, const float* xin, u8* smem) {
  u16* sA = (u16*)smem; u16* sB = sA + 128 * GS;
  const u16* MX = (const u16*)(p.ws + WS_MIXED);
  const u16* W = (const u16*)(p.ws + WS_WOUT);
  u16* xb1 = (u16*)(p.ws + WS_XB1);
  float* part1 = (float*)(p.ws + WS_PART1);
  const int tid_ = otid();
  const int lane = tid_ & 63, w = __builtin_amdgcn_readfirstlane(tid_ >> 6), lr = lane & 31, h = lane >> 5, wm = w >> 1, wn = w & 1;
  for (int tile = blockIdx.x; tile < 128 * 8; tile += gridDim.x) {
    const int nt = (tile >> 3) & 7, mt = ((tile >> 6) << 3) + (tile & 7);
    f32x16 acc[2][2]; zero_acc(acc);
    gemm_tile(acc, W + (size_t)nt * 128 * D, D, MX + (size_t)mt * 128 * D, D, D, sA, sB, nt * 128);
    float ssq[2] = {0.f, 0.f};
#pragma unroll
    for (int mi = 0; mi < 2; mi++)
#pragma unroll
      for (int ni = 0; ni < 2; ni++) {
        const int tok = mt * 128 + wn * 64 + ni * 32 + lr;
#pragma unroll
        for (int g4 = 0; g4 < 4; g4++) {
          const int f0 = nt * 128 + wm * 64 + mi * 32 + 8 * g4 + 4 * h;
          const size_t idx = (size_t)tok * D + f0;
          const f32x4 xi = *(const f32x4*)(xin + idx);
          f32x4 o;
          o.x = xi.x + acc[mi][ni][4 * g4]; o.y = xi.y + acc[mi][ni][4 * g4 + 1]; o.z = xi.z + acc[mi][ni][4 * g4 + 2]; o.w = xi.w + acc[mi][ni][4 * g4 + 3];
          *(f32x4*)(p.out + idx) = o;
          u32x2 ob; ob.x = pack2(o.x, o.y); ob.y = pack2(o.z, o.w);
          *(u32x2*)(xb1 + idx) = ob;
          ssq[ni] += (o.x * o.x + o.y * o.y) + (o.z * o.z + o.w * o.w);
        }
      }
#pragma unroll
    for (int ni = 0; ni < 2; ni++) {
      const float tot = ssq[ni] + __shfl_xor(ssq[ni], 32);
      if (h == 0) part1[(size_t)(mt * 128 + wn * 64 + ni * 32 + lr) * 16 + nt * 2 + wm] = tot;
    }
  }
}

DI void phase_ple(const Params& p, u8* smem) {
  u16* sA = (u16*)smem; u16* sB = sA + 128 * GS;
  const u16* xb = (const u16*)(p.ws + WS_XB1);
  u16* xb0 = (u16*)(p.ws + WS_XB);
  float* part0 = (float*)(p.ws + WS_PART0);
  const u16* pb = (const u16*)(p.ws + WS_PB);
  const u16* WP = (const u16*)(p.ws + WS_WPLE);
  const u16* WG = (const u16*)(p.ws + WS_WPG);
  const float* part1 = (const float*)(p.ws + WS_PART1);
  const int tid_ = otid();
  const int lane = tid_ & 63, w = __builtin_amdgcn_readfirstlane(tid_ >> 6), lr = lane & 31, h = lane >> 5, wm = w >> 1, wn = w & 1;
  for (int tile = blockIdx.x; tile < 128 * 8; tile += gridDim.x) {
    const int nt = (tile >> 3) & 7, mt = ((tile >> 6) << 3) + (tile & 7);
    unsigned gp[2][2][8];
    {
      f32x16 ag[2][2]; zero_acc(ag);
      gemm_tile(ag, WG + (size_t)nt * 128 * D, D, xb + (size_t)mt * 128 * D, D, D, sA, sB, nt * 128);
#pragma unroll
      for (int mi = 0; mi < 2; mi++)
#pragma unroll
        for (int ni = 0; ni < 2; ni++) {
          const float rv = rinv_of(part1, mt * 128 + wn * 64 + ni * 32 + lr);
#pragma unroll
          for (int r = 0; r < 8; r++) gp[mi][ni][r] = pack2(sigm(ag[mi][ni][2 * r] * rv), sigm(ag[mi][ni][2 * r + 1] * rv));
        }
    }
    f32x16 ap[2][2]; zero_acc(ap);
    gemm_tile1(ap, WP + (size_t)nt * 128 * PLE, PLE, pb + (size_t)mt * 128 * PLE, PLE, PLE, sA, sB, (nt & 3) * 64);
    float ssq[2] = {0.f, 0.f};
#pragma unroll
    for (int mi = 0; mi < 2; mi++)
#pragma unroll
      for (int ni = 0; ni < 2; ni++) {
        const int tok = mt * 128 + wn * 64 + ni * 32 + lr;
#pragma unroll
        for (int g4 = 0; g4 < 4; g4++) {
          const int f0 = nt * 128 + wm * 64 + mi * 32 + 8 * g4 + 4 * h;
          const size_t idx = (size_t)tok * D + f0;
          f32x4 o = *(const f32x4*)(p.out + idx);
          o.x += ap[mi][ni][4 * g4] * bflo(gp[mi][ni][2 * g4]);
          o.y += ap[mi][ni][4 * g4 + 1] * bfhi(gp[mi][ni][2 * g4]);
          o.z += ap[mi][ni][4 * g4 + 2] * bflo(gp[mi][ni][2 * g4 + 1]);
          o.w += ap[mi][ni][4 * g4 + 3] * bfhi(gp[mi][ni][2 * g4 + 1]);
          *(f32x4*)(p.out + idx) = o;
          u32x2 ob; ob.x = pack2(o.x, o.y); ob.y = pack2(o.z, o.w);
          *(u32x2*)(xb0 + idx) = ob;
          ssq[ni] += (o.x * o.x + o.y * o.y) + (o.z * o.z + o.w * o.w);
        }
      }
#pragma unroll
    for (int ni = 0; ni < 2; ni++) {
      const float tot = ssq[ni] + __shfl_xor(ssq[ni], 32);
      if (h == 0) part0[(size_t)(mt * 128 + wn * 64 + ni * 32 + lr) * 16 + nt * 2 + wm] = tot;
    }
  }
}

template <int DV, int KW>
DI void attn_gload(u32x4 (&kr)[KW / 32], u32x4 (&vr)[DV / 32], const u16* Kb, int ldk, const u16* Vb, size_t ldv, int key0, const int tid) {
  constexpr int CPR = KW / 8;
  key0 = __builtin_amdgcn_readfirstlane(key0);
  const char* kbase = (const char*)(Kb + (size_t)key0 * ldk);
  const unsigned koff = (unsigned)(((tid / CPR) * ldk + (tid % CPR) * 8) * 2);
#pragma unroll
  for (int i = 0; i < KW / 32; i++) kr[i] = *(const u32x4*)(kbase + (size_t)((256 / CPR) * i) * ldk * 2 + koff);
  const char* vbase = (const char*)(Vb + key0);
  const unsigned voff = (unsigned)(((tid >> 3) * (unsigned)ldv + (tid & 7) * 8) * 2);
#pragma unroll
  for (int i = 0; i < DV / 32; i++) vr[i] = *(const u32x4*)(vbase + (size_t)(32 * i) * ldv * 2 + voff);
}
template <int DV, int KW>
DI void attn_sstore(const u32x4 (&kr)[KW / 32], const u32x4 (&vr)[DV / 32], u16* Ks, u16* Vts, const int tid) {
  constexpr int CPR = KW / 8, KS = KW + 8;
#pragma unroll
  for (int i = 0; i < KW / 32; i++) { int c = tid + 256 * i; int row = c / CPR, kc = c % CPR; *(u32x4*)&Ks[row * KS + kc * 8] = kr[i]; }
#pragma unroll
  for (int i = 0; i < DV / 32; i++) {
    int c = tid + 256 * i; int d = c >> 3, kc = c & 7;
    u32x2 lo; lo.x = vr[i].x; lo.y = vr[i].y; u32x2 hi; hi.x = vr[i].z; hi.y = vr[i].w;
    *(u32x2*)&Vts[d * 68 + kc * 8] = lo; *(u32x2*)&Vts[d * 68 + kc * 8 + 4] = hi;
  }
}
template <int KW>
DI void attn_qk(f32x16& s0, f32x16& s1, const bf16x8 (&qf)[4], const u16* Ks, int kcol, const int tid) {
  constexpr int KS = KW + 8;
  const int lane = tid & 63, lr = lane & 31, h = lane >> 5;
#pragma unroll
  for (int r = 0; r < 16; r++) { s0[r] = 0.f; s1[r] = 0.f; }
  {
    const u16* k0p = &Ks[lr * KS + kcol + h * 8];
    const u16* k1p = &Ks[(32 + lr) * KS + kcol + h * 8];
    bf16x8 a0[4], a1[4];
#pragma unroll
    for (int s = 0; s < 4; s++) { a0[s] = *(const bf16x8*)(k0p + s * 16); a1[s] = *(const bf16x8*)(k1p + s * 16); }
    __builtin_amdgcn_sched_barrier(0);
#pragma unroll
    for (int s = 0; s < 4; s++) { s0 = MFMA32(a0[s], qf[s], s0); s1 = MFMA32(a1[s], qf[s], s1); }
  }
}
DI bf16x8 packp(const f32x16& s, int s2) {
  u32x4 u;
  if (s2 == 0) { u[0] = pack2(s[0], s[1]); u[1] = pack2(s[2], s[3]); u[2] = pack2(s[4], s[5]); u[3] = pack2(s[6], s[7]); }
  else { u[0] = pack2(s[8], s[9]); u[1] = pack2(s[10], s[11]); u[2] = pack2(s[12], s[13]); u[3] = pack2(s[14], s[15]); }
  return __builtin_bit_cast(bf16x8, u);
}
template <int DV>
DI void attn_pv(f32x16 (&O)[DV / 32], const f32x16& s0, const f32x16& s1, const u16* Vts, const int tid) {
  const int lane = tid & 63, lr = lane & 31, h = lane >> 5;
  bf16x8 pf[2][2];
  pf[0][0] = packp(s0, 0); pf[0][1] = packp(s0, 1); pf[1][0] = packp(s1, 0); pf[1][1] = packp(s1, 1);
#pragma unroll
  for (int db = 0; db < DV / 32; db++) {
    bf16x8 a[4];
#pragma unroll
    for (int q = 0; q < 4; q++) {
      const u16* vp = &Vts[(db * 32 + lr) * 68 + q * 16 + 4 * h];
      s16x4 lo = *(const s16x4*)vp, hi = *(const s16x4*)(vp + 8);
      a[q] = __builtin_shufflevector(lo, hi, 0, 1, 2, 3, 4, 5, 6, 7);
    }
    __builtin_amdgcn_sched_barrier(0);
#pragma unroll
    for (int q = 0; q < 4; q++) O[db] = MFMA32(a[q], pf[q >> 1][q & 1], O[db]);
  }
}
template <int DV, int KW, class MF>
DI void attn_tile(f32x16 (&O)[DV / 32], float& m, float& l, const bf16x8 (&qf)[4], const u16* Ks, int kcol, const u16* Vts, MF valid, const bool MASKED, const bool lane_on, const int tid) {
  const int lane = tid & 63, h = lane >> 5;
  f32x16 s0, s1;
  attn_qk<KW>(s0, s1, qf, Ks, kcol, tid);
  float mx = MINIT;
  if (MASKED) {
#pragma unroll
    for (int r = 0; r < 16; r++) {
      const int kl = crow(r, h);
      s0[r] = valid(kl) ? s0[r] : MASKV;
      s1[r] = valid(32 + kl) ? s1[r] : MASKV;
    }
  }
#pragma unroll
  for (int r = 0; r < 16; r++) mx = fmaxf(mx, fmaxf(s0[r], s1[r]));
  mx = fmaxf(mx, __shfl_xor(mx, 32)) * SCL2;
  const bool need = lane_on && (mx > m + 8.f);
  const float mn = need ? mx : m;
  if (__any(need)) {
    const float alpha = ex2(m - mn);
    l *= alpha;
#pragma unroll
    for (int db = 0; db < DV / 32; db++)
#pragma unroll
      for (int r = 0; r < 16; r++) O[db][r] *= alpha;
  }
  m = mn;
  const float msub = lane_on ? mn : 3.0e38f;
  float ls = 0.f;
#pragma unroll
  for (int r = 0; r < 16; r++) { s0[r] = ex2(fmaf(s0[r], SCL2, -msub)); s1[r] = ex2(fmaf(s1[r], SCL2, -msub)); ls += s0[r] + s1[r]; }
  l += ls;
  attn_pv<DV>(O, s0, s1, Vts, tid);
}
template <int DV, int KW, class MF, class TM, class LO>
DI void attn_run(f32x16 (&O)[DV / 32], float& m, float& l, const bf16x8 (&qf)[4], int kcol, const u16* Kb, int ldk, const u16* Vb, size_t ldv, u64 tiles, MF mf, TM tmask, LO lon, u16* Ks, u16* Vts, const int tid) {
  u32x4 kr[KW / 32], vr[DV / 32];
  if (!tiles) return;
  attn_gload<DV, KW>(kr, vr, Kb, ldk, Vb, ldv, __builtin_ctzll(tiles) * 64, tid);
  while (tiles) {
    const int kt = __builtin_amdgcn_readfirstlane(__builtin_ctzll(tiles));
    tiles &= tiles - 1;
    __syncthreads();
    attn_sstore<DV, KW>(kr, vr, Ks, Vts, tid);
    __syncthreads();
    if (tiles) attn_gload<DV, KW>(kr, vr, Kb, ldk, Vb, ldv, __builtin_ctzll(tiles) * 64, tid);
    attn_tile<DV, KW>(O, m, l, qf, Ks, kcol, Vts, [&](int kl) { return mf(kt, kl); }, tmask(kt), lon(kt), tid);
  }
}

DI void phaseA_item(const Params& p, int layer, int item, u8* smem, float lam, float lam_init) {
  const int tid = otid(), lane = tid & 63, w = __builtin_amdgcn_readfirstlane(tid >> 6), lr = lane & 31, h = lane >> 5;
  const int qt = 63 - (item >> 4), bh = item & 15, b = bh >> 2, hd = bh & 3;
  const int comp = w & 1, th = w >> 1;
  const int t = qt * 64 + th * 32 + lr;
  const size_t grow = (size_t)b * S + t;
  u16* Ks = (u16*)smem; u16* Vts = (u16*)(smem + 64 * 136 * 2);
  const u16* aq = (const u16*)(p.ws + WS_AQ);
  const u16* ak = (const u16*)(p.ws + WS_AK) + (size_t)b * S * 512 + hd * 128;
  const u16* avt = (const u16*)(p.ws + WS_AVT) + (size_t)(hd * 128) * T + (size_t)b * S;
  bf16x8 qf[4];
#pragma unroll
  for (int s = 0; s < 4; s++) qf[s] = *(const bf16x8*)(aq + grow * 512 + hd * 128 + comp * 64 + s * 16 + h * 8);
  f32x16 O[4];
#pragma unroll
  for (int db = 0; db < 4; db++)
#pragma unroll
    for (int r = 0; r < 16; r++) O[db][r] = 0.f;
  float m = MINIT, l = 0.f;
  const u64 tiles = (qt == 63) ? ~0ull : ((1ull << (qt + 1)) - 1ull);
  attn_run<128, 128>(O, m, l, qf, comp * 64, ak, 512, avt, (size_t)T, tiles, [&](int kt, int kl) { return kt * 64 + kl <= t; }, [&](int kt) { return kt == qt; }, [&](int kt) { return true; }, Ks, Vts, tid);
  l += __shfl_xor(l, 32);
  const float il = 1.f / l;
  __syncthreads();
  float* ex = (float*)smem;
  if (comp == 1) {
#pragma unroll
    for (int db = 0; db < 4; db++)
#pragma unroll
      for (int r = 0; r < 16; r++) ex[(th * 128 + db * 32 + crow(r, h)) * 32 + lr] = O[db][r] * il;
  }
  __syncthreads();
  if (comp == 0) {
    float ss = 0.f;
#pragma unroll
    for (int db = 0; db < 4; db++)
#pragma unroll
      for (int r = 0; r < 16; r++) {
        float v = O[db][r] * il - lam * ex[(th * 128 + db * 32 + crow(r, h)) * 32 + lr];
        O[db][r] = v; ss += v * v;
      }
    ss += __shfl_xor(ss, 32);
    const float rn = rsqrtf(ss * (1.f / 128.f) + 1e-6f) * (1.f - lam_init);
    const float* sg = p.dsub + layer * 128;
    u16* Ob = (u16*)(p.ws + WS_O) + grow * OW + hd * 128;
#pragma unroll
    for (int db = 0; db < 4; db++)
#pragma unroll
      for (int g = 0; g < 4; g++) {
        int d0 = db * 32 + 8 * g + 4 * h;
        u32x2 o;
        o.x = pack2(O[db][4 * g] * rn * sg[d0], O[db][4 * g + 1] * rn * sg[d0 + 1]);
        o.y = pack2(O[db][4 * g + 2] * rn * sg[d0 + 2], O[db][4 * g + 3] * rn * sg[d0 + 3]);
        *(u32x2*)(Ob + d0) = o;
      }
  }
}

DI unsigned ordkey(float v) { unsigned u = __float_as_uint(v); return (u & 0x80000000u) ? ~u : (u | 0x80000000u); }

DI void phaseB_item(const Params& p, int item, u8* smem) {
  const int tid = otid(), lane = tid & 63, w = __builtin_amdgcn_readfirstlane(tid >> 6), lr = lane & 31, h = lane >> 5;
  const int b = item & 3, t0 = (1023 - (item >> 2)) * 4;
  unsigned* sc = (unsigned*)smem;
  const int nk = t0 + 4, ntile = (nk + 31) >> 5;
  const u16* iq = (const u16*)(p.ws + WS_IQ);
  const u16* ik = (const u16*)(p.ws + WS_IK) + (size_t)b * S * 64;
  const float* misc = (const float*)(p.ws + WS_MISC);
  {
    bf16x8 af[4];
    const int qi_a = lr >> 3, hd_a = lr & 7;
#pragma unroll
    for (int s = 0; s < 4; s++) af[s] = *(const bf16x8*)(iq + ((size_t)b * S + t0 + qi_a) * 512 + hd_a * 64 + s * 16 + h * 8);
    float wt[4][4];
#pragma unroll
    for (int qi = 0; qi < 4; qi++)
#pragma unroll
      for (int j = 0; j < 4; j++) wt[qi][j] = misc[((size_t)b * S + t0 + qi) * 32 + 4 * h + j] * (0.35355339059327373f * 0.125f);
    for (int kt = w; kt < ntile; kt += 16) {
      int ktv[4];
      bf16x8 bfr[4][4];
#pragma unroll
      for (int u = 0; u < 4; u++) {
        ktv[u] = (kt + 4 * u < ntile) ? kt + 4 * u : kt;
        const u16* kp = ik + (size_t)(ktv[u] * 32 + lr) * 64 + h * 8;
#pragma unroll
        for (int s = 0; s < 4; s++) bfr[u][s] = *(const bf16x8*)(kp + s * 16);
      }
#pragma unroll
      for (int u = 0; u < 4; u++) {
        f32x16 acc;
#pragma unroll
        for (int r = 0; r < 16; r++) acc[r] = 0.f;
#pragma unroll
        for (int s = 0; s < 4; s++) acc = MFMA32(af[s], bfr[u][s], acc);
        const int key = ktv[u] * 32 + lr;
#pragma unroll
        for (int qi = 0; qi < 4; qi++) {
          float v = wt[qi][0] * fmaxf(acc[qi * 4], 0.f) + wt[qi][1] * fmaxf(acc[qi * 4 + 1], 0.f) + wt[qi][2] * fmaxf(acc[qi * 4 + 2], 0.f) + wt[qi][3] * fmaxf(acc[qi * 4 + 3], 0.f);
          v += __shfl_xor(v, 32);
          const unsigned uu = (key <= t0 + qi) ? ordkey(v) : 0u;
          if ((qi >> 1) == h) sc[qi * 4096 + key] = uu;
        }
      }
    }
  }
  __syncthreads();
  const int t = t0 + w, n = t + 1;
  unsigned* row = sc + w * 4096;
  u16* list = (u16*)row;
  float* P = (float*)(row + 1024);
  int cnt;
  if (n <= 256) {
    cnt = n;
#pragma unroll
    for (int i = 0; i < 4; i++) { int sl = lane + 64 * i; list[sl] = (u16)(sl < n ? sl : 0); }
  } else {
    cnt = 256;
    unsigned kreg[64];
#pragma unroll
    for (int i = 0; i < 64; i++) {
      unsigned v = 0u;
      if (i * 64 < n) { int k = i * 64 + lane; v = (k <= t) ? row[k] : 0u; }
      kreg[i] = v;
    }
    const int ngrp = (n + 511) >> 9;
    unsigned Tv = 0u;
#pragma unroll 1
    for (int bit = 31; bit >= 24; --bit) {
      const unsigned cand = Tv | (1u << bit);
      int c = 0;
#pragma unroll
      for (int g = 0; g < 8; g++)
        if (g < ngrp) {
#pragma unroll
          for (int j = 0; j < 8; j++) c += (kreg[g * 8 + j] >= cand) ? 1 : 0;
        }
      c = wsum_dpp(c);
      if (c >= 256) Tv = cand;
    }
    int need = 256;
    if (Tv < 0xff000000u) {
      const unsigned up = Tv + (1u << 24);
      int c = 0;
#pragma unroll
      for (int g = 0; g < 8; g++)
        if (g < ngrp) {
#pragma unroll
          for (int j = 0; j < 8; j++) c += (kreg[g * 8 + j] >= up) ? 1 : 0;
        }
      need = 256 - wsum_dpp(c);
    }
    unsigned* hist = row + 3072;
    unsigned prefix = Tv >> 24;
#pragma unroll 1
    for (int shift = 16; shift >= 0; shift -= 8) {
      { u32x4 z = {0u, 0u, 0u, 0u}; ((u32x4*)hist)[lane] = z; }
      __builtin_amdgcn_fence(__ATOMIC_RELEASE, "workgroup");
#pragma unroll
      for (int g = 0; g < 8; g++)
        if (g < ngrp) {
#pragma unroll
          for (int j = 0; j < 8; j++) {
            const unsigned k = kreg[g * 8 + j];
            if ((k >> (shift + 8)) == prefix) __hip_atomic_fetch_add(&hist[(k >> shift) & 255u], 1u, __ATOMIC_RELAXED, __HIP_MEMORY_SCOPE_WORKGROUP);
          }
          __builtin_amdgcn_sched_barrier(0);
        }
      __builtin_amdgcn_fence(__ATOMIC_ACQ_REL, "workgroup");
      const u32x4 cb = ((const u32x4*)hist)[63 - lane];
      const int c3 = (int)cb.w, c2 = (int)cb.z, c1 = (int)cb.y, c0 = (int)cb.x;
      const int ssum = (c3 + c2) + (c1 + c0);
      const int P = wscan_dpp(ssum);
      const u64 bal = __ballot(P >= need);
      const int L = __builtin_ctzll(bal);
      int accu = P - ssum;
      int binl, ndl;
      const int top = 255 - 4 * lane;
      if (accu + c3 >= need) { binl = top; ndl = need - accu; }
      else {
        accu += c3;
        if (accu + c2 >= need) { binl = top - 1; ndl = need - accu; }
        else {
          accu += c2;
          if (accu + c1 >= need) { binl = top - 2; ndl = need - accu; }
          else { accu += c1; binl = top - 3; ndl = need - accu; }
        }
      }
      const int bin = __builtin_amdgcn_readlane(binl, L);
      need = __builtin_amdgcn_readlane(ndl, L);
      prefix = (prefix << 8) | (unsigned)bin;
    }
    Tv = prefix;
    int base = 0, eqs = 0;
#pragma unroll
    for (int g = 0; g < 8; g++)
      if (g < ngrp) {
#pragma unroll
        for (int j = 0; j < 8; j++) {
          const int i = g * 8 + j;
          const bool gt = kreg[i] > Tv, eq = kreg[i] == Tv;
          const u64 beq = __ballot(eq);
          const int erank = eqs + mbcnt(beq);
          const bool sel = gt || (eq && erank < need);
          const u64 bs = __ballot(sel);
          if (sel) list[base + mbcnt(bs)] = (u16)(i * 64 + lane);
          base += __popcll(bs); eqs += __popcll(beq);
        }
      }
  }
  const u16* bk = (const u16*)(p.ws + WS_BK) + (size_t)b * S * 64;
  const u16* bv = (const u16*)(p.ws + WS_BV) + (size_t)b * S * 64;
  {
    const u16* bq = (const u16*)(p.ws + WS_BQ) + ((size_t)b * S + t) * 512;
    bf16x8 qb[4];
#pragma unroll
    for (int s = 0; s < 4; s++) {
      bf16x8 z = {0, 0, 0, 0, 0, 0, 0, 0};
      qb[s] = (lr < 8) ? *(const bf16x8*)(bq + lr * 64 + s * 16 + h * 8) : z;
    }
#pragma unroll 2
    for (int kb2 = 0; kb2 < 2; kb2++) {
      bf16x8 ka[4][4];
#pragma unroll
      for (int q4 = 0; q4 < 4; q4++) {
        const int kidx = list[(kb2 * 4 + q4) * 32 + lr];
#pragma unroll
        for (int s = 0; s < 4; s++) ka[q4][s] = *(const bf16x8*)(bk + (size_t)kidx * 64 + s * 16 + h * 8);
      }
#pragma unroll
      for (int q4 = 0; q4 < 4; q4++) {
        f32x16 acc;
#pragma unroll
        for (int r = 0; r < 16; r++) acc[r] = 0.f;
#pragma unroll
        for (int s = 0; s < 4; s++) acc = MFMA32(ka[q4][s], qb[s], acc);
        if (lr < 8) {
#pragma unroll
          for (int r = 0; r < 16; r++) P[((kb2 * 4 + q4) * 32 + crow(r, h)) * 8 + lr] = acc[r] * SCL2;
        }
      }
    }
  }
  {
    f32x4 pa[4], pb[4];
#pragma unroll
    for (int i = 0; i < 4; i++) { const int sl = lane + 64 * i; pa[i] = *(const f32x4*)&P[sl * 8]; pb[i] = *(const f32x4*)&P[sl * 8 + 4]; }
#pragma unroll
    for (int hd = 0; hd < 8; hd++) {
      float sv[4];
      float mx = MASKV;
#pragma unroll
      for (int i = 0; i < 4; i++) {
        const bool ok = (lane + 64 * i) < cnt;
        float x = (hd < 4) ? pa[i][hd & 3] : pb[i][hd & 3];
        sv[i] = ok ? x : MASKV; mx = fmaxf(mx, sv[i]);
      }
      mx = wmaxf(mx);
      float sm = 0.f;
#pragma unroll
      for (int i = 0; i < 4; i++) { sv[i] = ex2(sv[i] - mx); sm += sv[i]; }
      sm = wsum(sm);
      const float is = 1.f / sm;
#pragma unroll
      for (int i = 0; i < 4; i++) { if (hd < 4) pa[i][hd & 3] = sv[i] * is; else pb[i][hd & 3] = sv[i] * is; }
    }
#pragma unroll
    for (int i = 0; i < 4; i++) { const int sl = lane + 64 * i; *(f32x4*)&P[sl * 8] = pa[i]; *(f32x4*)&P[sl * 8 + 4] = pb[i]; }
  }
  {
    const int kg = lane >> 3, dc = lane & 7;
    float acc[8][8];
#pragma unroll
    for (int hd = 0; hd < 8; hd++)
#pragma unroll
      for (int j = 0; j < 8; j++) acc[hd][j] = 0.f;
    const int nit = (cnt + 7) >> 3;
    const int nb = (nit + 3) >> 2;
    u32x4 vcur[4], vnxt[4];
#pragma unroll
    for (int u = 0; u < 4; u++) {
      const int kidx = list[u * 8 + kg];
      vcur[u] = *(const u32x4*)(bv + (size_t)kidx * 64 + dc * 8);
    }
#pragma unroll 1
    for (int bt = 0; bt < nb; bt++) {
      if (bt + 1 < nb) {
#pragma unroll
        for (int u = 0; u < 4; u++) {
          const int kidx = list[(bt + 1) * 32 + u * 8 + kg];
          vnxt[u] = *(const u32x4*)(bv + (size_t)kidx * 64 + dc * 8);
        }
      }
#pragma unroll
      for (int u = 0; u < 4; u++) {
        const int slot = bt * 32 + u * 8 + kg;
        const f32x4 qa = *(const f32x4*)&P[slot * 8], qb2 = *(const f32x4*)&P[slot * 8 + 4];
        const u32x4 vv = vcur[u];
        float vf[8];
        vf[0] = bflo(vv.x); vf[1] = bfhi(vv.x); vf[2] = bflo(vv.y); vf[3] = bfhi(vv.y);
        vf[4] = bflo(vv.z); vf[5] = bfhi(vv.z); vf[6] = bflo(vv.w); vf[7] = bfhi(vv.w);
#pragma unroll
        for (int j = 0; j < 8; j++) {
          acc[0][j] += qa.x * vf[j]; acc[1][j] += qa.y * vf[j]; acc[2][j] += qa.z * vf[j]; acc[3][j] += qa.w * vf[j];
          acc[4][j] += qb2.x * vf[j]; acc[5][j] += qb2.y * vf[j]; acc[6][j] += qb2.z * vf[j]; acc[7][j] += qb2.w * vf[j];
        }
      }
#pragma unroll
      for (int u = 0; u < 4; u++) vcur[u] = vnxt[u];
    }
    const bool b5 = (lane & 32) != 0, b4 = (lane & 16) != 0, b3 = (lane & 8) != 0;
    float a1[4][8], a2[2][8], a3[8];
#pragma unroll
    for (int hd = 0; hd < 4; hd++)
#pragma unroll
      for (int j = 0; j < 8; j++) {
        float send = b5 ? acc[hd][j] : acc[hd + 4][j];
        float keep = b5 ? acc[hd + 4][j] : acc[hd][j];
        a1[hd][j] = keep + __shfl_xor(send, 32);
      }
#pragma unroll
    for (int hd = 0; hd < 2; hd++)
#pragma unroll
      for (int j = 0; j < 8; j++) {
        float send = b4 ? a1[hd][j] : a1[hd + 2][j];
        float keep = b4 ? a1[hd + 2][j] : a1[hd][j];
        a2[hd][j] = keep + __shfl_xor(send, 16);
      }
#pragma unroll
    for (int j = 0; j < 8; j++) {
      float send = b3 ? a2[0][j] : a2[1][j];
      float keep = b3 ? a2[1][j] : a2[0][j];
      a3[j] = keep + __shfl_xor(send, 8);
    }
    u32x4 o;
    o.x = pack2(a3[0], a3[1]); o.y = pack2(a3[2], a3[3]); o.z = pack2(a3[4], a3[5]); o.w = pack2(a3[6], a3[7]);
    u16* Ob = (u16*)(p.ws + WS_O) + ((size_t)b * S + t) * OW + 512;
    *(u32x4*)(Ob + kg * 64 + dc * 8) = o;
  }
}

DI float gelu_tanh(float x) {
  float u = 0.7978845608028654f * (x + 0.044715f * x * x * x);
  float th = 1.f - 2.f / (1.f + __expf(2.f * u));
  return 0.5f * x * (1.f + th);
}
DI void phaseCmp_item(const Params& p, int layer, int item, u8* smem) {
  const int tid = otid(), lane = tid & 63, w = __builtin_amdgcn_readfirstlane(tid >> 6), lr = lane & 31, h = lane >> 5;
  const int kv = item >> 6, rt = item & 63, bg = rt >> 3, n0 = (rt & 7) * 32, b = bg >> 1, g = bg & 1;
  const u16* src = (const u16*)(p.ws + (kv ? WS_CVC : WS_CKC));
  const float* pe = (kv ? p.pe_v : p.pe_k) + (size_t)layer * 32 * 64;
  const u16* w1 = (const u16*)(p.ws + WS_CW1) + (size_t)kv * 128 * 2048;
  const u16* w2 = (const u16*)(p.ws + WS_CW2) + (size_t)kv * 64 * 128;
  u16* hid = (u16*)smem;
  const int n = n0 + lr;
  f32x16 acc;
#pragma unroll
  for (int r = 0; r < 16; r++) acc[r] = 0.f;
  const u16* w1p = w1 + (size_t)(32 * w + lr) * 2048 + h * 8;
#pragma unroll 4
  for (int s = 0; s < 128; s++) {
    const int lp = s >> 2, d0 = (s & 3) * 16 + h * 8;
    int tok = 16 * n + lp; if (tok > S - 1) tok = S - 1;
    u32x4 raw = *(const u32x4*)(src + ((size_t)b * S + tok) * 128 + g * 64 + d0);
    f32x4 pa = *(const f32x4*)(pe + lp * 64 + d0), pb = *(const f32x4*)(pe + lp * 64 + d0 + 4);
    u32x4 u;
    u[0] = pack2(bflo(raw.x) + pa.x, bfhi(raw.x) + pa.y); u[1] = pack2(bflo(raw.y) + pa.z, bfhi(raw.y) + pa.w);
    u[2] = pack2(bflo(raw.z) + pb.x, bfhi(raw.z) + pb.y); u[3] = pack2(bflo(raw.w) + pb.z, bfhi(raw.w) + pb.w);
    bf16x8 a = __builtin_bit_cast(bf16x8, u);
    bf16x8 bfr = *(const bf16x8*)(w1p + s * 16);
    acc = MFMA32(a, bfr, acc);
  }
  __syncthreads();
#pragma unroll
  for (int r = 0; r < 16; r++) hid[crow(r, h) * 136 + 32 * w + lr] = f2bf(gelu_tanh(acc[r]));
  __syncthreads();
  if (w < 2) {
    f32x16 o;
#pragma unroll
    for (int r = 0; r < 16; r++) o[r] = 0.f;
#pragma unroll
    for (int s = 0; s < 8; s++) {
      bf16x8 a = *(const bf16x8*)&hid[lr * 136 + s * 16 + h * 8];
      bf16x8 bfr = *(const bf16x8*)(w2 + (size_t)(32 * w + lr) * 128 + s * 16 + h * 8);
      o = MFMA32(a, bfr, o);
    }
    const int d = 32 * w + lr;
    if (kv == 0) {
      u16* kc = (u16*)(p.ws + WS_KC);
#pragma unroll
      for (int r = 0; r < 16; r++) { int nn = n0 + crow(r, h); kc[((size_t)bg * 256 + nn) * 64 + d] = (nn < 255) ? f2bf(o[r]) : (u16)0; }
    } else {
      u16* vct = (u16*)(p.ws + WS_VCT);
#pragma unroll
      for (int g4 = 0; g4 < 4; g4++) {
        int nn0 = n0 + 8 * g4 + 4 * h;
        float v3 = (nn0 + 3 < 255) ? o[4 * g4 + 3] : 0.f;
        u32x2 ov; ov.x = pack2(o[4 * g4], o[4 * g4 + 1]); ov.y = pack2(o[4 * g4 + 2], v3);
        *(u32x2*)(vct + ((size_t)bg * 64 + d) * 256 + nn0) = ov;
      }
    }
  }
}

DI void phaseC_item(const Params& p, int item, u8* smem) {
  const int tid = otid(), lane = tid & 63, w = __builtin_amdgcn_readfirstlane(tid >> 6), lr = lane & 31, h = lane >> 5;
  const int qt = 127 - (item >> 3), bg = item & 7, b = bg >> 1, g = bg & 1;
  const int q0 = qt * 32, t = q0 + lr, hh = g * 4 + w;
  const size_t grow = (size_t)b * S + t;
  u16* Ks = (u16*)smem; u16* Vts = (u16*)(smem + 9216);
  float* imp = (float*)(smem + 17920);
  u64* msk = (u64*)(smem + 50688);
  const float* cosT = (const float*)(p.ws + WS_COS);
  const float* sinT = (const float*)(p.ws + WS_SIN);
  const float* misc = (const float*)(p.ws + WS_MISC);
  bf16x8 qf[4], qr[4];
#pragma unroll
  for (int s = 0; s < 4; s++) { qf[s] = *(const bf16x8*)((const u16*)(p.ws + WS_CQ) + grow * 512 + hh * 64 + s * 16 + h * 8); qr[s] = qf[s]; }
  {
    u32x4 u;
    float rr[8];
#pragma unroll
    for (int j = 0; j < 8; j++) {
      float x = bf2f((u16)qf[0][j]);
      float o = __shfl_xor(x, 32);
      float cs = cosT[grow * 8 + j], sn = sinT[grow * 8 + j];
      rr[j] = (h == 0) ? (x * cs - o * sn) : (x * cs + o * sn);
    }
    u[0] = pack2(rr[0], rr[1]); u[1] = pack2(rr[2], rr[3]); u[2] = pack2(rr[4], rr[5]); u[3] = pack2(rr[6], rr[7]);
    qr[0] = __builtin_bit_cast(bf16x8, u);
  }
  __syncthreads();
  {
    f32x4 z; z.x = 0.f; z.y = 0.f; z.z = 0.f; z.w = 0.f;
#pragma unroll
    for (int i = 0; i < 8; i++) ((f32x4*)imp)[tid + 256 * i] = z;
  }
  f32x16 Ot[2];
#pragma unroll
  for (int db = 0; db < 2; db++)
#pragma unroll
    for (int r = 0; r < 16; r++) Ot[db][r] = 0.f;
  {
    const u16* Kc = (const u16*)(p.ws + WS_KC) + (size_t)bg * 256 * 64;
    const u16* Vc = (const u16*)(p.ws + WS_VCT) + (size_t)bg * 64 * 256;
    const int nct = ((q0 >> 4) >> 6) + 1;
    float mc = MINIT, lc = 0.f;
    u32x4 kr[2], vr[2];
    for (int kt = 0; kt < nct; kt++) {
      attn_gload<64, 64>(kr, vr, Kc, 64, Vc, 256, kt * 64, tid);
      __syncthreads();
      attn_sstore<64, 64>(kr, vr, Ks, Vts, tid);
      __syncthreads();
      f32x16 s0, s1;
      attn_qk<64>(s0, s1, qf, Ks, 0, tid);
      float mx = MINIT;
#pragma unroll
      for (int r = 0; r < 16; r++) {
        int n0 = kt * 64 + crow(r, h), n1 = n0 + 32;
        s0[r] = (16 * n0 + 31 <= t) ? s0[r] * SCL2 : MASKV;
        s1[r] = (16 * n1 + 31 <= t) ? s1[r] * SCL2 : MASKV;
        mx = fmaxf(mx, fmaxf(s0[r], s1[r]));
      }
      mx = fmaxf(mx, __shfl_xor(mx, 32));
      const float mn = fmaxf(mc, mx);
      float ls = 0.f;
#pragma unroll
      for (int r = 0; r < 16; r++) ls += ex2(s0[r] - mn) + ex2(s1[r] - mn);
      lc = lc * ex2(mc - mn) + ls;
      mc = mn;
    }
    lc += __shfl_xor(lc, 32);
    const float ilc = (lc > 0.f) ? 1.f / lc : 0.f;
    float xprev = 0.f;
    f32x16 Oc[2];
#pragma unroll
    for (int db = 0; db < 2; db++)
#pragma unroll
      for (int r = 0; r < 16; r++) Oc[db][r] = 0.f;
    for (int kt = 0; kt < nct; kt++) {
      attn_gload<64, 64>(kr, vr, Kc, 64, Vc, 256, kt * 64, tid);
      __syncthreads();
      attn_sstore<64, 64>(kr, vr, Ks, Vts, tid);
      __syncthreads();
      f32x16 s0, s1;
      attn_qk<64>(s0, s1, qf, Ks, 0, tid);
#pragma unroll
      for (int r = 0; r < 16; r++) {
        int n0 = kt * 64 + crow(r, h), n1 = n0 + 32;
        s0[r] = (16 * n0 + 31 <= t) ? ex2(s0[r] * SCL2 - mc) * ilc : 0.f;
        s1[r] = (16 * n1 + 31 <= t) ? ex2(s1[r] * SCL2 - mc) * ilc : 0.f;
      }
#pragma unroll
      for (int g4 = 0; g4 < 4; g4++) {
        float G = s0[4 * g4] + s0[4 * g4 + 1] + s0[4 * g4 + 2] + s0[4 * g4 + 3];
        float X = __shfl_xor(s0[4 * g4 + 3], 32);
        float val = G + (h ? X : xprev);
        xprev = X;
        imp[(w * 32 + lr) * 64 + kt * 16 + 2 * g4 + h] = val;
      }
#pragma unroll
      for (int g4 = 0; g4 < 4; g4++) {
        float G = s1[4 * g4] + s1[4 * g4 + 1] + s1[4 * g4 + 2] + s1[4 * g4 + 3];
        float X = __shfl_xor(s1[4 * g4 + 3], 32);
        float val = G + (h ? X : xprev);
        xprev = X;
        imp[(w * 32 + lr) * 64 + kt * 16 + 8 + 2 * g4 + h] = val;
      }
      attn_pv<64>(Oc, s0, s1, Vts, tid);
    }
    if (nct < 4 && h == 0) imp[(w * 32 + lr) * 64 + nct * 16] = xprev;
    const float g0 = sigm(misc[grow * 32 + 8 + hh * 3 + 0]);
#pragma unroll
    for (int db = 0; db < 2; db++)
#pragma unroll
      for (int r = 0; r < 16; r++) Ot[db][r] = g0 * Oc[db][r];
  }
  __syncthreads();
  {
#pragma unroll 1
    for (int i = 0; i < 8; i++) {
      const int tok = w * 8 + i, tt = q0 + tok;
      float v = imp[(0 * 32 + tok) * 64 + lane] + imp[(1 * 32 + tok) * 64 + lane];
      v += imp[(2 * 32 + tok) * 64 + lane];
      v += imp[(3 * 32 + tok) * 64 + lane];
      if (lane == (tt >> 6) || lane == 0) v = 1.0e4f;
      if (lane * 64 > tt) v = -INFINITY;
      int rank = 0;
#pragma unroll 8
      for (int mm = 0; mm < 64; mm++) { float o = __shfl(v, mm); rank += ((o > v) || (o == v && mm < lane)) ? 1 : 0; }
      const u64 bm = __ballot(rank < 16);
      if (lane == 0) msk[tok] = bm;
    }
  }
  __syncthreads();
  float* park = imp + (w * 32) * 64 + lane;
#pragma unroll
  for (int db = 0; db < 2; db++)
#pragma unroll
    for (int r = 0; r < 16; r++) park[(db * 16 + r) * 64] = Ot[db][r];
  {
    const u64 mymask = msk[lr];
    unsigned lo = (unsigned)mymask, hi = (unsigned)(mymask >> 32);
    for (int o = 16; o; o >>= 1) { lo |= __shfl_xor(lo, o); hi |= __shfl_xor(hi, o); }
    lo |= __shfl_xor(lo, 32); hi |= __shfl_xor(hi, 32);
    u64 um = ((u64)hi << 32) | lo;
    const int nkt = ((q0 + 31) >> 6) + 1;
    if (nkt < 64) um &= ((1ull << nkt) - 1ull);
    f32x16 Os[2];
#pragma unroll
    for (int db = 0; db < 2; db++)
#pragma unroll
      for (int r = 0; r < 16; r++) Os[db][r] = 0.f;
    float ms = MINIT, ls = 0.f;
    const u16* Kb = (const u16*)(p.ws + WS_CKS) + (size_t)b * S * 128 + g * 64;
    const u16* Vb = (const u16*)(p.ws + WS_CVST) + (size_t)(g * 64) * T + (size_t)b * S;
    attn_run<64, 64>(Os, ms, ls, qr, 0, Kb, 128, Vb, (size_t)T, um,
                     [&](int kt, int kl) { return kt * 64 + kl <= t; }, [&](int kt) { return kt == (q0 >> 6); }, [&](int kt) { return ((mymask >> kt) & 1ull) != 0ull; }, Ks, Vts, tid);
    ls += __shfl_xor(ls, 32);
    const float g1 = sigm(misc[grow * 32 + 8 + hh * 3 + 1]) / ls;
#pragma unroll
    for (int db = 0; db < 2; db++)
#pragma unroll
      for (int r = 0; r < 16; r++) park[(db * 16 + r) * 64] += g1 * Os[db][r];
  }
  {
    int lo_t = q0 - 511; if (lo_t < 0) lo_t = 0;
    const int kt0 = lo_t >> 6, kt1 = (q0 + 31) >> 6;
    u64 tiles = (kt1 == 63) ? ~0ull : ((1ull << (kt1 + 1)) - 1ull);
    tiles &= ~((1ull << kt0) - 1ull);
    f32x16 Ow[2];
#pragma unroll
    for (int db = 0; db < 2; db++)
#pragma unroll
      for (int r = 0; r < 16; r++) Ow[db][r] = 0.f;
    float mw = MINIT, lw = 0.f;
    const u16* Kb = (const u16*)(p.ws + WS_CKW) + (size_t)b * S * 128 + g * 64;
    const u16* Vb = (const u16*)(p.ws + WS_CVWT) + (size_t)(g * 64) * T + (size_t)b * S;
    attn_run<64, 64>(Ow, mw, lw, qr, 0, Kb, 128, Vb, (size_t)T, tiles,
                     [&](int kt, int kl) { int key = kt * 64 + kl; return (key <= t) && (key > t - 512); }, [&](int kt) { return !((kt * 64 + 63 <= q0) && (kt * 64 > q0 + 31 - 512)); }, [&](int kt) { return true; }, Ks, Vts, tid);
    lw += __shfl_xor(lw, 32);
    const float g2 = sigm(misc[grow * 32 + 8 + hh * 3 + 2]) / lw;
#pragma unroll
    for (int db = 0; db < 2; db++)
#pragma unroll
      for (int r = 0; r < 16; r++) Ot[db][r] = park[(db * 16 + r) * 64] + g2 * Ow[db][r];
  }
  u16* Ob = (u16*)(p.ws + WS_O) + grow * OW + 1024 + hh * 64;
#pragma unroll
  for (int db = 0; db < 2; db++)
#pragma unroll
    for (int g4 = 0; g4 < 4; g4++) {
      int d0 = db * 32 + 8 * g4 + 4 * h;
      u32x2 o; o.x = pack2(Ot[db][4 * g4], Ot[db][4 * g4 + 1]); o.y = pack2(Ot[db][4 * g4 + 2], Ot[db][4 * g4 + 3]);
      *(u32x2*)(Ob + d0) = o;
    }
}

DI int fetch_item(int* ctr, u8* smem) {
  volatile int* mbox = (volatile int*)smem;
  __syncthreads();
  if (threadIdx.x == 0) *mbox = atomicAdd(ctr, 1);
  __syncthreads();
  int it = __builtin_amdgcn_readfirstlane(*mbox);
  __syncthreads();
  return it;
}

constexpr int XB_CNT = 0, XB_SUB = 1024, XB_GEN = 2048, XB_TOP = 3072, XB_TOPGEN = 3136;
DI unsigned xb_ld(unsigned* p) { return __hip_atomic_load(p, __ATOMIC_RELAXED, __HIP_MEMORY_SCOPE_AGENT); }
DI unsigned xb_add(unsigned* p, unsigned v) { return __hip_atomic_fetch_add(p, v, __ATOMIC_RELAXED, __HIP_MEMORY_SCOPE_AGENT); }
DI unsigned xcc_id() { return (unsigned)__builtin_amdgcn_s_getreg((3 << 11) | 20) & 0xFu; }
struct GridBar { unsigned* bar; unsigned x, nloc, nx, k; };
DI void grid_barrier(GridBar& b) {
  asm volatile("s_waitcnt vmcnt(0)" ::: "memory");
  __syncthreads();
  if (threadIdx.x == 0) {
    unsigned* bar = b.bar;
    const unsigned k = ++b.k;
    if (b.nloc == 0u) {
      const unsigned G = gridDim.x;
      for (;;) {
        unsigned sum = 0u, cnt = 0u, mine = 0u;
#pragma unroll
        for (unsigned j = 0; j < 16; ++j) { const unsigned c = xb_ld(bar + XB_CNT + 64 * j); sum += c; cnt += (c > 0u) ? 1u : 0u; mine = (j == b.x) ? c : mine; }
        if (sum == G) { b.nloc = mine; b.nx = cnt; break; }
        __builtin_amdgcn_s_sleep(1);
      }
    }
    const unsigned old = xb_add(bar + XB_SUB + 64 * b.x, 1u);
    if (old + 1u == k * b.nloc) {
      __builtin_amdgcn_fence(__ATOMIC_RELEASE, "agent");
      asm volatile("s_waitcnt vmcnt(0)" ::: "memory");
      const unsigned og = xb_add(bar + XB_TOP, 1u);
      if (og + 1u == k * b.nx) xb_add(bar + XB_TOPGEN, 1u);
      else while (xb_ld(bar + XB_TOPGEN) < k) __builtin_amdgcn_s_sleep(1);
      __builtin_amdgcn_fence(__ATOMIC_ACQUIRE, "agent");
      xb_add(bar + XB_GEN + 64 * b.x, 1u);
      asm volatile("s_waitcnt vmcnt(0)" ::: "memory");
    } else {
      while (xb_ld(bar + XB_GEN + 64 * b.x) < k) __builtin_amdgcn_s_sleep(1);
      __builtin_amdgcn_fence(__ATOMIC_ACQUIRE, "agent");
      asm volatile("s_waitcnt vmcnt(0)" ::: "memory");
    }
  }
  __syncthreads();
}

__global__ void __launch_bounds__(256, 2) fwd_megakernel(Params p) {
  cg::grid_group grid = cg::this_grid();
  __shared__ __attribute__((aligned(16))) u8 smem[65536];
  u8* ws = p.ws;
  int* ctr = (int*)(ws + WS_CTR);
  GridBar gb; gb.bar = (unsigned*)(ws + WS_BAR); gb.x = xcc_id(); gb.nloc = 0u; gb.nx = 0u; gb.k = 0u;
  if (threadIdx.x == 0) (void)xb_add(gb.bar + XB_CNT + 64 * gb.x, 1u);
  rope_tables(p);
  prep_layer(p, 0, smem);
  norm_rows(p.x, (u16*)(ws + WS_XB), (float*)(ws + WS_PART0));
  if (p.out == nullptr) grid.sync();
  grid_barrier(gb);
#pragma unroll 1
  for (int layer = 0; layer < NL; layer++) {
    phase_gemm1(p, smem);
    grid_barrier(gb);
    {
      const float lam_init = 0.8f - 0.6f * __expf(-0.3f * (float)layer);
      const float* lp = p.dlam + layer * 256;
      const int lane = otid() & 63;
      float s1 = wsum(lp[lane] * lp[64 + lane]);
      float s2 = wsum(lp[128 + lane] * lp[192 + lane]);
      const float lam = __expf(s1) - __expf(s2) + lam_init;
      unsigned acq_mask = 0u;
#pragma unroll 1
      for (int dq = 0; dq < 8; dq++) {
        const int q = (int)((gb.x + (unsigned)dq) & 7u);
        int* qctr = ctr + layer * 8 + q;
        int* cdone = ctr + 16 + layer * 8 + q;
        for (;;) {
          const int i = fetch_item(qctr, smem);
          if (i >= 16 + 384 + 384) break;
          if (i < 16) {
            phaseCmp_item(p, layer, (i >> 3) * 64 + q * 8 + (i & 7), smem);
            __syncthreads();
            if (threadIdx.x == 0) { __threadfence(); atomicAdd(cdone, 1); }
          } else {
            const int u = i - 16;
            const int half = (u >= 384) ? 1 : 0;
            const int u2 = u - half * 384;
            const int g = u2 / 3, r = u2 - g * 3;
            if (r != 0) {
              const int gbl = half * 256 + g * 2 + (r - 1);
              phaseB_item(p, (2 * gbl + (q >> 2)) * 4 + (q & 3), smem);
            } else if (half == 0) {
              phaseA_item(p, layer, (g & 63) * 16 + 2 * q + (g >> 6), smem, lam, lam_init);
            } else {
              if (!((acq_mask >> q) & 1u)) {
                if (threadIdx.x == 0) {
                  while (__hip_atomic_load(cdone, __ATOMIC_RELAXED, __HIP_MEMORY_SCOPE_AGENT) < 16) __builtin_amdgcn_s_sleep(8);
                  __threadfence();
                }
                __syncthreads();
                __builtin_amdgcn_fence(__ATOMIC_ACQUIRE, "agent");
                acq_mask |= 1u << q;
              }
              phaseC_item(p, g * 8 + q, smem);
            }
          }
        }
      }
    }
    grid_barrier(gb);
    phase_gates(p, smem);
    grid_barrier(gb);
    phase_mix(p, smem);
    grid_barrier(gb);
    convert_p(p.p + (size_t)layer * T * PLE, (u16*)(ws + WS_PB));
    phase_outproj(p, layer == 0 ? p.x : p.out, smem);
    grid_barrier(gb);
    phase_ple(p, smem);
    grid_barrier(gb);
    if (layer + 1 < NL) {
      prep_layer(p, layer + 1, smem);
      grid_barrier(gb);
    } else {
      final_norm(p.out, p.fin_g, (const float*)(ws + WS_PART0));
    }
  }
}

extern "C" void kernel_launch(void* const* d_in, const int* in_sizes, int n_in, void* d_out, int out_size,
                              void* d_ws, size_t ws_size, hipStream_t stream) {
  static int grid_blocks = 0;
  if (!grid_blocks) {
    int dev = 0, cus = 0, per_cu = 0;
    (void)hipGetDevice(&dev);
    (void)hipDeviceGetAttribute(&cus, hipDeviceAttributeMultiprocessorCount, dev);
    (void)hipOccupancyMaxActiveBlocksPerMultiprocessor(&per_cu, fwd_megakernel, 256, 0);
    if (per_cu > 2) per_cu = 2;
    if (per_cu < 1) per_cu = 1;
    grid_blocks = cus * per_cu;
    if (ws_size < WS_END) fprintf(stderr, "kernel_launch: workspace too small: %zu < %zu\n", ws_size, (size_t)WS_END);
  }
  Params p{};
  p.x = (const float*)d_in[0]; p.p = (const float*)d_in[1]; p.pos = (const int*)d_in[2];
  p.norm_g = (const float*)d_in[3]; p.w_in = (const float*)d_in[4]; p.dlam = (const float*)d_in[5]; p.dsub = (const float*)d_in[6];
  p.pe_k = (const float*)d_in[7]; p.w1_k = (const float*)d_in[8]; p.w2_k = (const float*)d_in[9];
  p.pe_v = (const float*)d_in[10]; p.w1_v = (const float*)d_in[11]; p.w2_v = (const float*)d_in[12];
  p.w_up = (const float*)d_in[13]; p.w_out = (const float*)d_in[14]; p.ple_g = (const float*)d_in[15];
  p.w_ple = (const float*)d_in[16]; p.w_pg = (const float*)d_in[17]; p.fin_g = (const float*)d_in[18];
  p.out = (float*)d_out; p.ws = (u8*)d_ws;
  for (int j = 0; j < 8; j++) p.inv[j] = (float)pow(500000.0, -(double)(2 * j) / 16.0);
  (void)hipMemsetAsync((u8*)d_ws + WS_CTR, 0, 256, stream);
  (void)hipMemsetAsync((u8*)d_ws + WS_BAR, 0, 16384, stream);
  void* args[] = {&p};
  hipError_t e = hipLaunchCooperativeKernel((void*)fwd_megakernel, dim3(grid_blocks), dim3(256), args, 0, stream);
  if (e != hipSuccess) fprintf(stderr, "cooperative launch failed: %s (grid %d)\n", hipGetErrorString(e), grid_blocks);
}
```

```cpp
#include <hip/hip_runtime.h>
#include <hip/hip_cooperative_groups.h>
#include <cstdio>
#include <cmath>
namespace cg = cooperative_groups;

#define DI __device__ __forceinline__
typedef unsigned short u16;
typedef unsigned char u8;
typedef unsigned long long u64;
typedef __attribute__((ext_vector_type(8))) short bf16x8;
typedef __attribute__((ext_vector_type(4))) short s16x4;
typedef __attribute__((ext_vector_type(16))) float f32x16;
typedef __attribute__((ext_vector_type(2))) float f32x2;
typedef __attribute__((ext_vector_type(2))) __bf16 bf16x2v;
typedef __attribute__((ext_vector_type(4))) unsigned u32x4;
typedef __attribute__((ext_vector_type(2))) unsigned u32x2;
typedef __attribute__((ext_vector_type(4))) float f32x4;
#define MFMA32(a, b, c) __builtin_amdgcn_mfma_f32_32x32x16_bf16((a), (b), (c), 0, 0, 0)

constexpr int NB = 4, S = 4096, T = NB * S, D = 1024, NL = 2, NIN = 8672, PLE = 256;
constexpr int OW = 1536;

constexpr size_t WS_W1 = 0;
constexpr size_t WS_WG = WS_W1 + (size_t)4096 * 1024 * 2;
constexpr size_t WS_WM = WS_WG + (size_t)1536 * 1024 * 2;
constexpr size_t WS_WUP = WS_WM + (size_t)3072 * 1024 * 2;
constexpr size_t WS_WOUT = WS_WUP + (size_t)3 * 1024 * 512 * 2;
constexpr size_t WS_WPLE = WS_WOUT + (size_t)1024 * 1024 * 2;
constexpr size_t WS_WPG = WS_WPLE + (size_t)1024 * 256 * 2;
constexpr size_t WS_CW1 = WS_WPG + (size_t)1024 * 1024 * 2;
constexpr size_t WS_CW2 = WS_CW1 + (size_t)2 * 128 * 2048 * 2;
constexpr size_t WS_COS = WS_CW2 + (size_t)2 * 64 * 128 * 2;
constexpr size_t WS_SIN = WS_COS + (size_t)T * 8 * 4;
constexpr size_t WS_CTR = WS_SIN + (size_t)T * 8 * 4;
constexpr size_t WS_XB = WS_CTR + 256;
constexpr size_t WS_RINV = WS_XB + (size_t)T * 1024 * 2;
constexpr size_t WS_AQ = WS_RINV + (size_t)T * 4;
constexpr size_t WS_AK = WS_AQ + (size_t)T * 512 * 2;
constexpr size_t WS_AVT = WS_AK + (size_t)T * 512 * 2;
constexpr size_t WS_BQ = WS_AVT + (size_t)T * 512 * 2;
constexpr size_t WS_BK = WS_BQ + (size_t)T * 512 * 2;
constexpr size_t WS_BV = WS_BK + (size_t)T * 64 * 2;
constexpr size_t WS_IQ = WS_BV + (size_t)T * 64 * 2;
constexpr size_t WS_IK = WS_IQ + (size_t)T * 512 * 2;
constexpr size_t WS_MISC = WS_IK + (size_t)T * 64 * 2;
constexpr size_t WS_CQ = WS_MISC + (size_t)T * 32 * 4;
constexpr size_t WS_CKC = WS_CQ + (size_t)T * 512 * 2;
constexpr size_t WS_CVC = WS_CKC + (size_t)T * 128 * 2;
constexpr size_t WS_CKS = WS_CVC + (size_t)T * 128 * 2;
constexpr size_t WS_CVST = WS_CKS + (size_t)T * 128 * 2;
constexpr size_t WS_CKW = WS_CVST + (size_t)T * 128 * 2;
constexpr size_t WS_CVWT = WS_CKW + (size_t)T * 128 * 2;
constexpr size_t WS_KC = WS_CVWT + (size_t)T * 128 * 2;
constexpr size_t WS_VCT = WS_KC + (size_t)NB * 2 * 256 * 64 * 2;
constexpr size_t WS_O = WS_VCT + (size_t)NB * 2 * 64 * 256 * 2;
constexpr size_t WS_PART0 = WS_O + (size_t)T * OW * 2;
constexpr size_t WS_PART1 = WS_PART0 + (size_t)T * 16 * 4;
constexpr size_t WS_BAR = WS_PART1 + (size_t)T * 16 * 4;
constexpr size_t WS_END = WS_BAR + 16384;
constexpr size_t WS_XB1 = WS_CQ;
static_assert(WS_XB1 + (size_t)T * 1024 * 2 <= WS_CKW, "xb1 alias overflows");
constexpr size_t WS_MIXED = WS_AQ;
constexpr size_t WS_PB = WS_BQ;
constexpr size_t WS_MG = WS_AVT;
static_assert(WS_MG + (size_t)T * 3072 * 2 <= WS_KC, "merge-gate alias overflows");

struct Params {
  const float *x, *p;
  const int* pos;
  const float *norm_g, *w_in, *dlam, *dsub, *pe_k, *w1_k, *w2_k, *pe_v, *w1_v, *w2_v, *w_up, *w_out, *ple_g, *w_ple, *w_pg, *fin_g;
  float* out;
  u8* ws;
  float inv[8];
};

DI unsigned pack2(float a, float b) { f32x2 v = {a, b}; return __builtin_bit_cast(unsigned, __builtin_convertvector(v, bf16x2v)); }
DI u16 f2bf(float a) { return (u16)(pack2(a, 0.f) & 0xffffu); }
DI float bf2f(u16 v) { return __uint_as_float(((unsigned)v) << 16); }
DI float bflo(unsigned v) { return __uint_as_float(v << 16); }
DI float bfhi(unsigned v) { return __uint_as_float(v & 0xffff0000u); }
DI int otid() { int t = threadIdx.x; asm volatile("" : "+v"(t)); return t; }
DI int crow(int r, int h) { return (r & 3) + 8 * (r >> 2) + 4 * h; }
DI float wsum(float v) { for (int o = 32; o; o >>= 1) v += __shfl_xor(v, o); return v; }
DI float wmaxf(float v) { for (int o = 32; o; o >>= 1) v = fmaxf(v, __shfl_xor(v, o)); return v; }
DI int wsum_dpp(int v) {
  v += __builtin_amdgcn_update_dpp(0, v, 0x111, 0xf, 0xf, true);
  v += __builtin_amdgcn_update_dpp(0, v, 0x112, 0xf, 0xf, true);
  v += __builtin_amdgcn_update_dpp(0, v, 0x114, 0xf, 0xf, true);
  v += __builtin_amdgcn_update_dpp(0, v, 0x118, 0xf, 0xf, true);
  v += __builtin_amdgcn_update_dpp(0, v, 0x142, 0xa, 0xf, true);
  v += __builtin_amdgcn_update_dpp(0, v, 0x143, 0xc, 0xf, true);
  return __builtin_amdgcn_readlane(v, 63);
}
DI int wscan_dpp(int v) {
  v += __builtin_amdgcn_update_dpp(0, v, 0x111, 0xf, 0xf, true);
  v += __builtin_amdgcn_update_dpp(0, v, 0x112, 0xf, 0xf, true);
  v += __builtin_amdgcn_update_dpp(0, v, 0x114, 0xf, 0xf, true);
  v += __builtin_amdgcn_update_dpp(0, v, 0x118, 0xf, 0xf, true);
  v += __builtin_amdgcn_update_dpp(0, v, 0x142, 0xa, 0xf, true);
  v += __builtin_amdgcn_update_dpp(0, v, 0x143, 0xc, 0xf, true);
  return v;
}
DI float ex2(float x) { return __builtin_amdgcn_exp2f(x); }
DI float sigm(float x) { return __builtin_amdgcn_rcpf(1.f + __expf(-x)); }
DI int mbcnt(u64 m) { return __builtin_amdgcn_mbcnt_hi((unsigned)(m >> 32), __builtin_amdgcn_mbcnt_lo((unsigned)m, 0)); }

DI float rinv_of(const float* part, int tok) {
  const f32x4* q = (const f32x4*)(part + (size_t)tok * 16);
  const f32x4 a = q[0], b = q[1], c = q[2], d = q[3];
  const float ss = ((a.x + a.y) + (a.z + a.w)) + ((b.x + b.y) + (b.z + b.w)) + (((c.x + c.y) + (c.z + c.w)) + ((d.x + d.y) + (d.z + d.w)));
  return rsqrtf(ss * (1.f / 1024.f) + 1e-6f);
}
constexpr float SCL2 = 0.125f * 1.4426950408889634f;
constexpr float MASKV = -3.0e38f, MINIT = -1.0e30f;

struct TJob { const float* src; u16* dst; const float* scale; int ld, K, N, map; };

DI TJob get_job(const Params& p, int l, int j) {
  TJob t; t.scale = nullptr; t.map = 0; t.src = nullptr; t.dst = nullptr; t.ld = 0; t.K = 0; t.N = 0;
  u8* ws = p.ws;
  if (j == 0) { t.src = p.w_in + (size_t)l * D * NIN; t.dst = (u16*)(ws + WS_W1); t.scale = p.norm_g + l * D; t.ld = NIN; t.K = 1024; t.N = 4096; t.map = 1; }
  else if (j == 1) { t.src = p.w_in + (size_t)l * D * NIN; t.dst = (u16*)(ws + WS_WG); t.scale = p.norm_g + l * D; t.ld = NIN; t.K = 1024; t.N = 1536; t.map = 2; }
  else if (j == 2) { t.src = p.w_in + (size_t)l * D * NIN; t.dst = (u16*)(ws + WS_WM); t.scale = p.norm_g + l * D; t.ld = NIN; t.K = 1024; t.N = 3072; t.map = 3; }
  else if (j <= 5) { int n = j - 3; t.src = p.w_up + (size_t)(l * 3 + n) * 512 * 1024; t.dst = (u16*)(ws + WS_WUP) + (size_t)n * 1024 * 512; t.ld = 1024; t.K = 512; t.N = 1024; }
  else if (j == 6) { t.src = p.w_out + (size_t)l * D * D; t.dst = (u16*)(ws + WS_WOUT); t.ld = 1024; t.K = 1024; t.N = 1024; }
  else if (j == 7) { t.src = p.w_ple + (size_t)l * PLE * D; t.dst = (u16*)(ws + WS_WPLE); t.ld = 1024; t.K = 256; t.N = 1024; }
  else if (j == 8) { t.src = p.w_pg + (size_t)l * D * D; t.dst = (u16*)(ws + WS_WPG); t.scale = p.ple_g + l * D; t.ld = 1024; t.K = 1024; t.N = 1024; }
  else if (j == 9) { t.src = p.w1_k + (size_t)l * 2048 * 128; t.dst = (u16*)(ws + WS_CW1); t.ld = 128; t.K = 2048; t.N = 128; }
  else if (j == 10) { t.src = p.w1_v + (size_t)l * 2048 * 128; t.dst = (u16*)(ws + WS_CW1) + 128 * 2048; t.ld = 128; t.K = 2048; t.N = 128; }
  else if (j == 11) { t.src = p.w2_k + (size_t)l * 128 * 64; t.dst = (u16*)(ws + WS_CW2); t.ld = 64; t.K = 128; t.N = 64; }
  else { t.src = p.w2_v + (size_t)l * 128 * 64; t.dst = (u16*)(ws + WS_CW2) + 64 * 128; t.ld = 64; t.K = 128; t.N = 64; }
  return t;
}
constexpr int NJOBS = 13;

DI int srccol(int map, int n) {
  if (map == 0) return n;
  if (map == 1) {
    if (n < 1536) return n;
    if (n < 2176) return n + 512;
    if (n < 2760) return n + 1024;
    if (n < 2784) return n + 2816;
    if (n < 2816) return -1;
    return n + 968;
  }
  if (map == 2) { if (n < 512) return n + 1536; if (n < 1024) return n + 2176; return n + 4040; }
  return n + 5600;
}

DI void prep_tile(const TJob& j, int tile, float* sm) {
  const int ktiles = j.K >> 6;
  const int nt = tile / ktiles, kt = tile - nt * ktiles;
  const int n0 = nt * 64, k0 = kt * 64;
  const int tid_ = otid();
  const int tx = tid_ & 63, ty = tid_ >> 6;
  const int sc = srccol(j.map, n0 + tx);
  float v[16];
#pragma unroll
  for (int i = 0; i < 16; i++) {
    const int k = ty + 4 * i;
    v[i] = (sc >= 0) ? j.src[(size_t)(k0 + k) * j.ld + sc] : 0.f;
  }
  if (j.scale) {
#pragma unroll
    for (int i = 0; i < 16; i++) v[i] *= j.scale[k0 + ty + 4 * i];
  }
  __syncthreads();
#pragma unroll
  for (int i = 0; i < 16; i++) sm[(ty + 4 * i) * 65 + tx] = v[i];
  __syncthreads();
  const int kc = (tid_ & 7) * 8;
#pragma unroll
  for (int pass = 0; pass < 2; pass++) {
    const int n = (tid_ >> 3) + 32 * pass;
    u32x4 o;
    o.x = pack2(sm[(kc + 0) * 65 + n], sm[(kc + 1) * 65 + n]);
    o.y = pack2(sm[(kc + 2) * 65 + n], sm[(kc + 3) * 65 + n]);
    o.z = pack2(sm[(kc + 4) * 65 + n], sm[(kc + 5) * 65 + n]);
    o.w = pack2(sm[(kc + 6) * 65 + n], sm[(kc + 7) * 65 + n]);
    *(u32x4*)(j.dst + (size_t)(n0 + n) * j.K + k0 + kc) = o;
  }
}

DI void prep_layer(const Params& p, int l, u8* smem, unsigned jmask = 0x1fffu) {
  int total = 0;
  for (int j = 0; j < NJOBS; j++) { if ((jmask >> j) & 1u) { TJob t = get_job(p, l, j); total += (t.N >> 6) * (t.K >> 6); } }
  for (int tile = blockIdx.x; tile < total; tile += gridDim.x) {
    int j = 0, tt = tile;
    TJob t = get_job(p, l, 0);
    for (;;) {
      const int n = ((jmask >> j) & 1u) ? (t.N >> 6) * (t.K >> 6) : 0;
      if (tt < n) break;
      tt -= n; j++; t = get_job(p, l, j);
    }
    prep_tile(t, tt, (float*)smem);
  }
}

DI void rope_tables(const Params& p) {
  float* cosT = (float*)(p.ws + WS_COS); float* sinT = (float*)(p.ws + WS_SIN);
  for (int i = blockIdx.x * 256 + otid(); i < T * 8; i += gridDim.x * 256) {
    int t = i >> 3, j = i & 7;
    float ang = (float)p.pos[t] * p.inv[j];
    double rev = (double)ang * 0.15915494309189535;
    rev -= floor(rev);
    if (rev >= 0.5) rev -= 1.0;
    float a = (float)(rev * 6.283185307179586);
    cosT[i] = cosf(a); sinT[i] = sinf(a);
  }
}

DI void norm_rows(const float* src, u16* xb, float* rinv) {
  const int tid_ = otid();
  const int wv = __builtin_amdgcn_readfirstlane(tid_ >> 6), lane = tid_ & 63;
  for (int row = blockIdx.x * 4 + wv; row < T; row += gridDim.x * 4) {
    const f32x4* s4 = (const f32x4*)(src + (size_t)row * D);
    f32x4 v[4]; float ss = 0.f;
#pragma unroll
    for (int i = 0; i < 4; i++) { v[i] = s4[lane + 64 * i]; ss += v[i].x * v[i].x + v[i].y * v[i].y + v[i].z * v[i].z + v[i].w * v[i].w; }
    ss = wsum(ss);
    if (lane < 16) rinv[(size_t)row * 16 + lane] = (lane == 0) ? ss : 0.f;
#pragma unroll
    for (int i = 0; i < 4; i++) { u32x2 o; o.x = pack2(v[i].x, v[i].y); o.y = pack2(v[i].z, v[i].w); ((u32x2*)(xb + (size_t)row * D))[lane + 64 * i] = o; }
  }
}
DI void final_norm(float* xo, const float* g, const float* part) {
  const int tid_ = otid();
  const int wv = __builtin_amdgcn_readfirstlane(tid_ >> 6), lane = tid_ & 63;
  for (int row = blockIdx.x * 4 + wv; row < T; row += gridDim.x * 4) {
    f32x4* s4 = (f32x4*)(xo + (size_t)row * D);
    const f32x4* g4 = (const f32x4*)g;
    const float r = rinv_of(part, row);
#pragma unroll
    for (int i = 0; i < 4; i++) { f32x4 v = s4[lane + 64 * i]; f32x4 gg = g4[lane + 64 * i]; f32x4 o; o.x = v.x * r * gg.x; o.y = v.y * r * gg.y; o.z = v.z * r * gg.z; o.w = v.w * r * gg.w; s4[lane + 64 * i] = o; }
  }
}
DI void convert_p(const float* src, u16* dst) {
  const int n4 = T * PLE / 4;
  for (int i = blockIdx.x * 256 + otid(); i < n4; i += gridDim.x * 256) {
    f32x4 v = ((const f32x4*)src)[i]; u32x2 o; o.x = pack2(v.x, v.y); o.y = pack2(v.z, v.w); ((u32x2*)dst)[i] = o;
  }
}

constexpr int GS = 72;
DI void gemm_compute_ktile(f32x16 (&acc)[2][2], const u16* sA, const u16* sB, int wm, int wn, int lr, int h) {
  const u16* pa = &sA[(wm * 64 + lr) * GS + h * 8];
  const u16* pb = &sB[(wn * 64 + lr) * GS + h * 8];
  bf16x8 fa[2][2], fb[2][2];
  fa[0][0] = *(const bf16x8*)(pa); fa[0][1] = *(const bf16x8*)(pa + 32 * GS);
  fb[0][0] = *(const bf16x8*)(pb); fb[0][1] = *(const bf16x8*)(pb + 32 * GS);
#pragma unroll
  for (int s = 0; s < 4; s++) {
    const int cur = s & 1, nxt = cur ^ 1;
    if (s < 3) {
      fa[nxt][0] = *(const bf16x8*)(pa + (s + 1) * 16); fa[nxt][1] = *(const bf16x8*)(pa + 32 * GS + (s + 1) * 16);
      fb[nxt][0] = *(const bf16x8*)(pb + (s + 1) * 16); fb[nxt][1] = *(const bf16x8*)(pb + 32 * GS + (s + 1) * 16);
    }
    __builtin_amdgcn_sched_barrier(0);
    acc[0][0] = MFMA32(fa[cur][0], fb[cur][0], acc[0][0]); acc[0][1] = MFMA32(fa[cur][0], fb[cur][1], acc[0][1]);
    acc[1][0] = MFMA32(fa[cur][1], fb[cur][0], acc[1][0]); acc[1][1] = MFMA32(fa[cur][1], fb[cur][1], acc[1][1]);
    __builtin_amdgcn_sched_barrier(0);
  }
}
DI void gemm_tile(f32x16 (&acc)[2][2], const u16* __restrict__ A, int lda, const u16* __restrict__ Bt, int ldb, int K, u16* sA, u16* sB, int kst = 0) {
  const int tid = otid(), lane = tid & 63, w = __builtin_amdgcn_readfirstlane(tid >> 6), lr = lane & 31, h = lane >> 5;
  const int wm = w >> 1, wn = w & 1;
  const int lrow = tid >> 3, lkc = (tid & 7) * 8;
  u32x4 ra0[4], rb0[4], ra1[4], rb1[4];
  const char* ap = (const char*)A; const char* bp = (const char*)Bt;
  const unsigned aoff = (unsigned)((lrow * lda + lkc) * 2), boff = (unsigned)((lrow * ldb + lkc) * 2);
  const int km = K - 1;
  {
    const int ka = kst & km, kb = (kst + 64) & km;
#pragma unroll
    for (int i = 0; i < 4; i++) { ra0[i] = *(const u32x4*)(ap + ((size_t)(32 * i) * lda + ka) * 2 + aoff); rb0[i] = *(const u32x4*)(bp + ((size_t)(32 * i) * ldb + ka) * 2 + boff); }
#pragma unroll
    for (int i = 0; i < 4; i++) { ra1[i] = *(const u32x4*)(ap + ((size_t)(32 * i) * lda + kb) * 2 + aoff); rb1[i] = *(const u32x4*)(bp + ((size_t)(32 * i) * ldb + kb) * 2 + boff); }
  }
  for (int k0 = 0; k0 < K; k0 += 128) {
    __syncthreads();
#pragma unroll
    for (int i = 0; i < 4; i++) { *(u32x4*)&sA[(lrow + 32 * i) * GS + lkc] = ra0[i]; *(u32x4*)&sB[(lrow + 32 * i) * GS + lkc] = rb0[i]; }
    __syncthreads();
    if (k0 + 128 < K) {
      const int kk = (kst + k0 + 128) & km;
#pragma unroll
      for (int i = 0; i < 4; i++) { ra0[i] = *(const u32x4*)(ap + ((size_t)(32 * i) * lda + kk) * 2 + aoff); rb0[i] = *(const u32x4*)(bp + ((size_t)(32 * i) * ldb + kk) * 2 + boff); }
    }
    gemm_compute_ktile(acc, sA, sB, wm, wn, lr, h);
    __syncthreads();
#pragma unroll
    for (int i = 0; i < 4; i++) { *(u32x4*)&sA[(lrow + 32 * i) * GS + lkc] = ra1[i]; *(u32x4*)&sB[(lrow + 32 * i) * GS + lkc] = rb1[i]; }
    __syncthreads();
    if (k0 + 192 < K) {
      const int kk = (kst + k0 + 192) & km;
#pragma unroll
      for (int i = 0; i < 4; i++) { ra1[i] = *(const u32x4*)(ap + ((size_t)(32 * i) * lda + kk) * 2 + aoff); rb1[i] = *(const u32x4*)(bp + ((size_t)(32 * i) * ldb + kk) * 2 + boff); }
    }
    gemm_compute_ktile(acc, sA, sB, wm, wn, lr, h);
  }
}
DI void gemm_tile1(f32x16 (&acc)[2][2], const u16* __restrict__ A, int lda, const u16* __restrict__ Bt, int ldb, int K, u16* sA, u16* sB, int kst = 0) {
  const int tid = otid(), lane = tid & 63, w = __builtin_amdgcn_readfirstlane(tid >> 6), lr = lane & 31, h = lane >> 5;
  const int wm = w >> 1, wn = w & 1;
  const int lrow = tid >> 3, lkc = (tid & 7) * 8;
  u32x4 ra[4], rb[4];
  const char* ap = (const char*)A; const char* bp = (const char*)Bt;
  const unsigned aoff = (unsigned)((lrow * lda + lkc) * 2), boff = (unsigned)((lrow * ldb + lkc) * 2);
  const int km = K - 1;
  {
    const int ka = kst & km;
#pragma unroll
    for (int i = 0; i < 4; i++) { ra[i] = *(const u32x4*)(ap + ((size_t)(32 * i) * lda + ka) * 2 + aoff); rb[i] = *(const u32x4*)(bp + ((size_t)(32 * i) * ldb + ka) * 2 + boff); }
  }
  for (int k0 = 0; k0 < K; k0 += 64) {
    __syncthreads();
#pragma unroll
    for (int i = 0; i < 4; i++) { *(u32x4*)&sA[(lrow + 32 * i) * GS + lkc] = ra[i]; *(u32x4*)&sB[(lrow + 32 * i) * GS + lkc] = rb[i]; }
    __syncthreads();
    if (k0 + 64 < K) {
      const int kk = (kst + k0 + 64) & km;
#pragma unroll
      for (int i = 0; i < 4; i++) { ra[i] = *(const u32x4*)(ap + ((size_t)(32 * i) * lda + kk) * 2 + aoff); rb[i] = *(const u32x4*)(bp + ((size_t)(32 * i) * ldb + kk) * 2 + boff); }
    }
    gemm_compute_ktile(acc, sA, sB, wm, wn, lr, h);
  }
}
DI void gemm_tile_w(f32x16 (&acc)[2][4], const u16* __restrict__ A, int lda, const u16* __restrict__ Bt, int ldb, int K, u16* sA, u16* sB, int kst) {
  const int tid = otid(), lane = tid & 63, w = __builtin_amdgcn_readfirstlane(tid >> 6), lr = lane & 31, h = lane >> 5;
  const int wm = w >> 1, wn = w & 1;
  const int lrow = tid >> 3, lkc = (tid & 7) * 8;
  u32x4 ra[4], rb[8];
  const char* ap = (const char*)A; const char* bp = (const char*)Bt;
  const unsigned aoff = (unsigned)((lrow * lda + lkc) * 2), boff = (unsigned)((lrow * ldb + lkc) * 2);
  const int km = K - 1;
  {
    const int ka = kst & km;
#pragma unroll
    for (int i = 0; i < 4; i++) ra[i] = *(const u32x4*)(ap + ((size_t)(32 * i) * lda + ka) * 2 + aoff);
#pragma unroll
    for (int i = 0; i < 8; i++) rb[i] = *(const u32x4*)(bp + ((size_t)(32 * i) * ldb + ka) * 2 + boff);
  }
  for (int k0 = 0; k0 < K; k0 += 64) {
    __syncthreads();
#pragma unroll
    for (int i = 0; i < 4; i++) *(u32x4*)&sA[(lrow + 32 * i) * GS + lkc] = ra[i];
#pragma unroll
    for (int i = 0; i < 8; i++) *(u32x4*)&sB[(lrow + 32 * i) * GS + lkc] = rb[i];
    __syncthreads();
    if (k0 + 64 < K) {
      const int kk = (kst + k0 + 64) & km;
#pragma unroll
      for (int i = 0; i < 4; i++) ra[i] = *(const u32x4*)(ap + ((size_t)(32 * i) * lda + kk) * 2 + aoff);
#pragma unroll
      for (int i = 0; i < 8; i++) rb[i] = *(const u32x4*)(bp + ((size_t)(32 * i) * ldb + kk) * 2 + boff);
    }
    const u16* pa = &sA[(wm * 64 + lr) * GS + h * 8];
    const u16* pb = &sB[(wn * 128 + lr) * GS + h * 8];
#pragma unroll
    for (int s = 0; s < 4; s++) {
      bf16x8 fa[2], fb[4];
      fa[0] = *(const bf16x8*)(pa + s * 16); fa[1] = *(const bf16x8*)(pa + 32 * GS + s * 16);
#pragma unroll
      for (int ni = 0; ni < 4; ni++) fb[ni] = *(const bf16x8*)(pb + ni * 32 * GS + s * 16);
#pragma unroll
      for (int ni = 0; ni < 4; ni++) { acc[0][ni] = MFMA32(fa[0], fb[ni], acc[0][ni]); acc[1][ni] = MFMA32(fa[1], fb[ni], acc[1][ni]); }
    }
  }
}
DI void zero_acc_w(f32x16 (&acc)[2][4]) {
#pragma unroll
  for (int a = 0; a < 2; a++)
#pragma unroll
    for (int b = 0; b < 4; b++)
#pragma unroll
      for (int r = 0; r < 16; r++) acc[a][b][r] = 0.f;
}
DI void zero_acc(f32x16 (&acc)[2][2]) {
#pragma unroll
  for (int a = 0; a < 2; a++)
#pragma unroll
    for (int b = 0; b < 2; b++)
#pragma unroll
      for (int r = 0; r < 16; r++) acc[a][b][r] = 0.f;
}

DI void p1_store_sw(const Params& p, const f32x16& acc, int fb, int tokbase, int lr, int h) {
  u8* ws = p.ws;
  const float* part = (const float*)(ws + WS_PART0);
  int kind = 0, ld = 512, c = 0; bool rope = false; u16* dst = nullptr;
  if (fb < 512) { dst = (u16*)(ws + WS_AQ); c = fb; rope = true; }
  else if (fb < 1024) { dst = (u16*)(ws + WS_AK); c = fb - 512; rope = true; }
  else if (fb < 1536) { kind = 1; dst = (u16*)(ws + WS_AVT); c = fb - 1024; }
  else if (fb < 2048) { dst = (u16*)(ws + WS_BQ); c = fb - 1536; rope = true; }
  else if (fb < 2112) { dst = (u16*)(ws + WS_BK); ld = 64; c = fb - 2048; rope = true; }
  else if (fb < 2176) { dst = (u16*)(ws + WS_BV); ld = 64; c = fb - 2112; }
  else if (fb < 2688) { dst = (u16*)(ws + WS_IQ); c = fb - 2176; rope = true; }
  else if (fb < 2752) { dst = (u16*)(ws + WS_IK); ld = 64; c = fb - 2688; rope = true; }
  else if (fb < 2784) { kind = 2; }
  else if (fb < 2816) { kind = 3; }
  else if (fb < 3328) { dst = (u16*)(ws + WS_CQ); c = fb - 2816; }
  else if (fb < 3456) { dst = (u16*)(ws + WS_CKC); ld = 128; c = fb - 3328; }
  else if (fb < 3584) { dst = (u16*)(ws + WS_CVC); ld = 128; c = fb - 3456; }
  else if (fb < 3712) { dst = (u16*)(ws + WS_CKS); ld = 128; c = fb - 3584; rope = true; }
  else if (fb < 3840) { kind = 1; dst = (u16*)(ws + WS_CVST); c = fb - 3712; }
  else if (fb < 3968) { dst = (u16*)(ws + WS_CKW); ld = 128; c = fb - 3840; rope = true; }
  else { kind = 1; dst = (u16*)(ws + WS_CVWT); c = fb - 3968; }
  if (kind == 3) return;
  rope = rope && ((fb & 32) == 0);
  const int tok = tokbase + lr;
  const float rv = rinv_of(part, tok);
  float v[16];
#pragma unroll
  for (int r = 0; r < 16; r++) v[r] = acc[r] * rv;
  if (rope) {
    const f32x4 cs = *(const f32x4*)((const float*)(ws + WS_COS) + (size_t)tok * 8 + 4 * h);
    const f32x4 sn = *(const f32x4*)((const float*)(ws + WS_SIN) + (size_t)tok * 8 + 4 * h);
#pragma unroll
    for (int j = 0; j < 4; j++) {
      const float x1 = v[j], x2 = v[4 + j];
      v[j] = x1 * cs[j] - x2 * sn[j];
      v[4 + j] = x2 * cs[j] + x1 * sn[j];
    }
  }
  if (kind == 0) {
#pragma unroll
    for (int g = 0; g < 4; g++) {
      u32x2 o; o.x = pack2(v[4 * g], v[4 * g + 1]); o.y = pack2(v[4 * g + 2], v[4 * g + 3]);
      *(u32x2*)(dst + (size_t)tok * ld + c + 8 * g + 4 * h) = o;
    }
  } else if (kind == 1) {
#pragma unroll
    for (int r = 0; r < 16; r++) dst[(size_t)(c + crow(r, h)) * T + tok] = f2bf(v[r]);
  } else {
    float* m = (float*)(ws + WS_MISC);
#pragma unroll
    for (int g = 0; g < 4; g++) {
      f32x4 o; o.x = v[4 * g]; o.y = v[4 * g + 1]; o.z = v[4 * g + 2]; o.w = v[4 * g + 3];
      *(f32x4*)(m + (size_t)tok * 32 + 8 * g + 4 * h) = o;
    }
  }
}

DI void phase_gemm1(const Params& p, u8* smem) {
  u16* sA = (u16*)smem; u16* sB = sA + 128 * GS;
  const u16* xb = (const u16*)(p.ws + WS_XB);
  const u16* W = (const u16*)(p.ws + WS_W1);
  const int tid_ = otid();
  const int lane = tid_ & 63, w = __builtin_amdgcn_readfirstlane(tid_ >> 6), lr = lane & 31, h = lane >> 5, wm = w >> 1, wn = w & 1;
  for (int tile = blockIdx.x; tile < 32 * 64; tile += gridDim.x) {
    const int ft = tile & 31, tt = tile >> 5;
    f32x16 acc[2][4]; zero_acc_w(acc);
    gemm_tile_w(acc, W + (size_t)ft * 128 * D, D, xb + (size_t)tt * 256 * D, D, D, sA, sB, (ft >> 3) * 256);
#pragma unroll
    for (int mi = 0; mi < 2; mi++)
#pragma unroll
      for (int ni = 0; ni < 4; ni++)
        p1_store_sw(p, acc[mi][ni], ft * 128 + wm * 64 + mi * 32, tt * 256 + wn * 128 + ni * 32, lr, h);
  }
}

DI void phase_gates(const Params& p, u8* smem) {
  u16* sA = (u16*)smem; u16* sB = sA + 128 * GS;
  const u16* xb = (const u16*)(p.ws + WS_XB);
  const u16* W = (const u16*)(p.ws + WS_WG);
  const float* part = (const float*)(p.ws + WS_PART0);
  u16* O = (u16*)(p.ws + WS_O);
  u16* MG = (u16*)(p.ws + WS_MG);
  const int tid_ = otid();
  const int lane = tid_ & 63, w = __builtin_amdgcn_readfirstlane(tid_ >> 6), lr = lane & 31, h = lane >> 5, wm = w >> 1, wn = w & 1;
  for (int tile = blockIdx.x; tile < 128 * 36; tile += gridDim.x) {
    const int nt = tile % 36, mt = tile / 36;
    f32x16 acc[2][2]; zero_acc(acc);
    gemm_tile(acc, W + (size_t)nt * 128 * D, D, xb + (size_t)mt * 128 * D, D, D, sA, sB, ((nt >> 3) & 3) * 256);
#pragma unroll
    for (int mi = 0; mi < 2; mi++)
#pragma unroll
      for (int ni = 0; ni < 2; ni++) {
        const int tok = mt * 128 + wn * 64 + ni * 32 + lr;
        const float rv = rinv_of(part, tok);
#pragma unroll
        for (int r = 0; r < 16; r++) {
          const float g = acc[mi][ni][r] * rv;
          const float sg = sigm(g);
          acc[mi][ni][r] = (nt < 12) ? g * sg : sg;
        }
        if (nt < 12) {
#pragma unroll
          for (int g4 = 0; g4 < 4; g4++) {
            const int f0 = nt * 128 + wm * 64 + mi * 32 + 8 * g4 + 4 * h;
            u16* op = O + (size_t)tok * OW + f0;
            const u32x2 ov = *(const u32x2*)op;
            u32x2 nv;
            nv.x = pack2(bflo(ov.x) * acc[mi][ni][4 * g4], bfhi(ov.x) * acc[mi][ni][4 * g4 + 1]);
            nv.y = pack2(bflo(ov.y) * acc[mi][ni][4 * g4 + 2], bfhi(ov.y) * acc[mi][ni][4 * g4 + 3]);
            *(u32x2*)op = nv;
          }
        } else {
          u32x4 a, b;
          a.x = pack2(acc[mi][ni][0], acc[mi][ni][1]); a.y = pack2(acc[mi][ni][2], acc[mi][ni][3]);
          a.z = pack2(acc[mi][ni][4], acc[mi][ni][5]); a.w = pack2(acc[mi][ni][6], acc[mi][ni][7]);
          b.x = pack2(acc[mi][ni][8], acc[mi][ni][9]); b.y = pack2(acc[mi][ni][10], acc[mi][ni][11]);
          b.z = pack2(acc[mi][ni][12], acc[mi][ni][13]); b.w = pack2(acc[mi][ni][14], acc[mi][ni][15]);
          u16* dst = MG + ((((size_t)mt * 24 + (nt - 12)) * 4 + (mi * 2 + ni)) * 256 + tid_) * 16;
          *(u32x4*)dst = a; *(u32x4*)(dst + 8) = b;
        }
      }
  }
}

DI void phase_mix(const Params& p, u8* smem) {
  u16* sA = (u16*)smem; u16* sB = sA + 128 * GS;
  const u16* WU = (const u16*)(p.ws + WS_WUP);
  const u16* O = (const u16*)(p.ws + WS_O);
  const u16* MG = (const u16*)(p.ws + WS_MG);
  u16* MX = (u16*)(p.ws + WS_MIXED);
  const int tid_ = otid();
  const int lane = tid_ & 63, w = __builtin_amdgcn_readfirstlane(tid_ >> 6), lr = lane & 31, h = lane >> 5, wm = w >> 1, wn = w & 1;
  for (int tile = blockIdx.x; tile < 128 * 8; tile += gridDim.x) {
    const int nt = (tile >> 3) & 7, mt = ((tile >> 6) << 3) + (tile & 7);
    f32x16 mix[2][2]; zero_acc(mix);
#pragma unroll 1
    for (int n = 0; n < 3; n++) {
      f32x16 acc[2][2]; zero_acc(acc);
      gemm_tile1(acc, WU + (size_t)(n * 1024 + nt * 128) * 512, 512, O + (size_t)mt * 128 * OW + n * 512, OW, 512, sA, sB, nt * 64);
#pragma unroll
      for (int mi = 0; mi < 2; mi++)
#pragma unroll
        for (int ni = 0; ni < 2; ni++) {
          const u16* src = MG + ((((size_t)mt * 24 + (n * 8 + nt)) * 4 + (mi * 2 + ni)) * 256 + tid_) * 16;
          const u32x4 a = *(const u32x4*)src, b = *(const u32x4*)(src + 8);
          mix[mi][ni][0] += bflo(a.x) * acc[mi][ni][0]; mix[mi][ni][1] += bfhi(a.x) * acc[mi][ni][1];
          mix[mi][ni][2] += bflo(a.y) * acc[mi][ni][2]; mix[mi][ni][3] += bfhi(a.y) * acc[mi][ni][3];
          mix[mi][ni][4] += bflo(a.z) * acc[mi][ni][4]; mix[mi][ni][5] += bfhi(a.z) * acc[mi][ni][5];
          mix[mi][ni][6] += bflo(a.w) * acc[mi][ni][6]; mix[mi][ni][7] += bfhi(a.w) * acc[mi][ni][7];
          mix[mi][ni][8] += bflo(b.x) * acc[mi][ni][8]; mix[mi][ni][9] += bfhi(b.x) * acc[mi][ni][9];
          mix[mi][ni][10] += bflo(b.y) * acc[mi][ni][10]; mix[mi][ni][11] += bfhi(b.y) * acc[mi][ni][11];
          mix[mi][ni][12] += bflo(b.z) * acc[mi][ni][12]; mix[mi][ni][13] += bfhi(b.z) * acc[mi][ni][13];
          mix[mi][ni][14] += bflo(b.w) * acc[mi][ni][14]; mix[mi][ni][15] += bfhi(b.w) * acc[mi][ni][15];
        }
    }
#pragma unroll
    for (int mi = 0; mi < 2; mi++)
#pragma unroll
      for (int ni = 0; ni < 2; ni++) {
        const int tok = mt * 128 + wn * 64 + ni * 32 + lr;
#pragma unroll
        for (int g4 = 0; g4 < 4; g4++) {
          const int f0 = nt * 128 + wm * 64 + mi * 32 + 8 * g4 + 4 * h;
          u32x2 o; o.x = pack2(mix[mi][ni][4 * g4], mix[mi][ni][4 * g4 + 1]); o.y = pack2(mix[mi][ni][4 * g4 + 2], mix[mi][ni][4 * g4 + 3]);
          *(u32x2*)(MX + (size_t)tok * D + f0) = o;
        }
      }
  }
}

DI void phase_outproj(const Params& p, const float* xin, u8* smem) {
  u16* sA = (u16*)smem; u16* sB = sA + 128 * GS;
  const u16* MX = (const u16*)(p.ws + WS_MIXED);
  const u16* W = (const u16*)(p.ws + WS_WOUT);
  u16* xb1 = (u16*)(p.ws + WS_XB1);
  float* part1 = (float*)(p.ws + WS_PART1);
  const int tid_ = otid();
  const int lane = tid_ & 63, w = __builtin_amdgcn_readfirstlane(tid_ >> 6), lr = lane & 31, h = lane >> 5, wm = w >> 1, wn = w & 1;
  for (int tile = blockIdx.x; tile < 128 * 8; tile += gridDim.x) {
    const int nt = (tile >> 3) & 7, mt = ((tile >> 6) << 3) + (tile & 7);
    f32x16 acc[2][2]; zero_acc(acc);
    gemm_tile(acc, W + (size_t)nt * 128 * D, D, MX + (size_t)mt * 128 * D, D, D, sA, sB, nt * 128);
    float ssq[2] = {0.f, 0.f};
#pragma unroll
    for (int mi = 0; mi < 2; mi++)
#pragma unroll
      for (int ni = 0; ni < 2; ni++) {
        const int tok = mt * 128 + wn * 64 + ni * 32 + lr;
#pragma unroll
        for (int g4 = 0; g4 < 4; g4++) {
          const int f0 = nt * 128 + wm * 64 + mi * 32 + 8 * g4 + 4 * h;
          const size_t idx = (size_t)tok * D + f0;
          const f32x4 xi = *(const f32x4*)(xin + idx);
          f32x4 o;
          o.x = xi.x + acc[mi][ni][4 * g4]; o.y = xi.y + acc[mi][ni][4 * g4 + 1]; o.z = xi.z + acc[mi][ni][4 * g4 + 2]; o.w = xi.w + acc[mi][ni][4 * g4 + 3];
          *(f32x4*)(p.out + idx) = o;
          u32x2 ob; ob.x = pack2(o.x, o.y); ob.y = pack2(o.z, o.w);
          *(u32x2*)(xb1 + idx) = ob;
          ssq[ni] += (o.x * o.x + o.y * o.y) + (o.z * o.z + o.w * o.w);
        }
      }
#pragma unroll
    for (int ni = 0; ni < 2; ni++) {
      const float tot = ssq[ni] + __shfl_xor(ssq[ni], 32);
      if (h == 0) part1[(size_t)(mt * 128 + wn * 64 + ni * 32 + lr) * 16 + nt * 2 + wm] = tot;
    }
  }
}

DI void phase_ple(const Params& p, u8* smem) {
  u16* sA = (u16*)smem; u16* sB = sA + 128 * GS;
  const u16* xb = (const u16*)(p.ws + WS_XB1);
  u16* xb0 = (u16*)(p.ws + WS_XB);
  float* part0 = (float*)(p.ws + WS_PART0);
  const u16* pb = (const u16*)(p.ws + WS_PB);
  const u16* WP = (const u16*)(p.ws + WS_WPLE);
  const u16* WG = (const u16*)(p.ws + WS_WPG);
  const float* part1 = (const float*)(p.ws + WS_PART1);
  const int tid_ = otid();
  const int lane = tid_ & 63, w = __builtin_amdgcn_readfirstlane(tid_ >> 6), lr = lane & 31, h = lane >> 5, wm = w >> 1, wn = w & 1;
  for (int tile = blockIdx.x; tile < 128 * 8; tile += gridDim.x) {
    const int nt = (tile >> 3) & 7, mt = ((tile >> 6) << 3) + (tile & 7);
    unsigned gp[2][2][8];
    {
      f32x16 ag[2][2]; zero_acc(ag);
      gemm_tile(ag, WG + (size_t)nt * 128 * D, D, xb + (size_t)mt * 128 * D, D, D, sA, sB, nt * 128);
#pragma unroll
      for (int mi = 0; mi < 2; mi++)
#pragma unroll
        for (int ni = 0; ni < 2; ni++) {
          const float rv = rinv_of(part1, mt * 128 + wn * 64 + ni * 32 + lr);
#pragma unroll
          for (int r = 0; r < 8; r++) gp[mi][ni][r] = pack2(sigm(ag[mi][ni][2 * r] * rv), sigm(ag[mi][ni][2 * r + 1] * rv));
        }
    }
    f32x16 ap[2][2]; zero_acc(ap);
    gemm_tile1(ap, WP + (size_t)nt * 128 * PLE, PLE, pb + (size_t)mt * 128 * PLE, PLE, PLE, sA, sB, (nt & 3) * 64);
    float ssq[2] = {0.f, 0.f};
#pragma unroll
    for (int mi = 0; mi < 2; mi++)
#pragma unroll
      for (int ni = 0; ni < 2; ni++) {
        const int tok = mt * 128 + wn * 64 + ni * 32 + lr;
#pragma unroll
        for (int g4 = 0; g4 < 4; g4++) {
          const int f0 = nt * 128 + wm * 64 + mi * 32 + 8 * g4 + 4 * h;
          const size_t idx = (size_t)tok * D + f0;
          f32x4 o = *(const f32x4*)(p.out + idx);
          o.x += ap[mi][ni][4 * g4] * bflo(gp[mi][ni][2 * g4]);
          o.y += ap[mi][ni][4 * g4 + 1] * bfhi(gp[mi][ni][2 * g4]);
          o.z += ap[mi][ni][4 * g4 + 2] * bflo(gp[mi][ni][2 * g4 + 1]);
          o.w += ap[mi][ni][4 * g4 + 3] * bfhi(gp[mi][ni][2 * g4 + 1]);
          *(f32x4*)(p.out + idx) = o;
          u32x2 ob; ob.x = pack2(o.x, o.y); ob.y = pack2(o.z, o.w);
          *(u32x2*)(xb0 + idx) = ob;
          ssq[ni] += (o.x * o.x + o.y * o.y) + (o.z * o.z + o.w * o.w);
        }
      }
#pragma unroll
    for (int ni = 0; ni < 2; ni++) {
      const float tot = ssq[ni] + __shfl_xor(ssq[ni], 32);
      if (h == 0) part0[(size_t)(mt * 128 + wn * 64 + ni * 32 + lr) * 16 + nt * 2 + wm] = tot;
    }
  }
}

template <int DV, int KW>
DI void attn_gload(u32x4 (&kr)[KW / 32], u32x4 (&vr)[DV / 32], const u16* Kb, int ldk, const u16* Vb, size_t ldv, int key0, const int tid) {
  constexpr int CPR = KW / 8;
  key0 = __builtin_amdgcn_readfirstlane(key0);
  const char* kbase = (const char*)(Kb + (size_t)key0 * ldk);
  const unsigned koff = (unsigned)(((tid / CPR) * ldk + (tid % CPR) * 8) * 2);
#pragma unroll
  for (int i = 0; i < KW / 32; i++) kr[i] = *(const u32x4*)(kbase + (size_t)((256 / CPR) * i) * ldk * 2 + koff);
  const char* vbase = (const char*)(Vb + key0);
  const unsigned voff = (unsigned)(((tid >> 3) * (unsigned)ldv + (tid & 7) * 8) * 2);
#pragma unroll
  for (int i = 0; i < DV / 32; i++) vr[i] = *(const u32x4*)(vbase + (size_t)(32 * i) * ldv * 2 + voff);
}
template <int DV, int KW>
DI void attn_sstore(const u32x4 (&kr)[KW / 32], const u32x4 (&vr)[DV / 32], u16* Ks, u16* Vts, const int tid) {
  constexpr int CPR = KW / 8, KS = KW + 8;
#pragma unroll
  for (int i = 0; i < KW / 32; i++) { int c = tid + 256 * i; int row = c / CPR, kc = c % CPR; *(u32x4*)&Ks[row * KS + kc * 8] = kr[i]; }
#pragma unroll
  for (int i = 0; i < DV / 32; i++) {
    int c = tid + 256 * i; int d = c >> 3, kc = c & 7;
    u32x2 lo; lo.x = vr[i].x; lo.y = vr[i].y; u32x2 hi; hi.x = vr[i].z; hi.y = vr[i].w;
    *(u32x2*)&Vts[d * 68 + kc * 8] = lo; *(u32x2*)&Vts[d * 68 + kc * 8 + 4] = hi;
  }
}
template <int KW>
DI void attn_qk(f32x16& s0, f32x16& s1, const bf16x8 (&qf)[4], const u16* Ks, int kcol, const int tid) {
  constexpr int KS = KW + 8;
  const int lane = tid & 63, lr = lane & 31, h = lane >> 5;
#pragma unroll
  for (int r = 0; r < 16; r++) { s0[r] = 0.f; s1[r] = 0.f; }
  {
    const u16* k0p = &Ks[lr * KS + kcol + h * 8];
    const u16* k1p = &Ks[(32 + lr) * KS + kcol + h * 8];
    bf16x8 a0[4], a1[4];
#pragma unroll
    for (int s = 0; s < 4; s++) { a0[s] = *(const bf16x8*)(k0p + s * 16); a1[s] = *(const bf16x8*)(k1p + s * 16); }
    __builtin_amdgcn_sched_barrier(0);
#pragma unroll
    for (int s = 0; s < 4; s++) { s0 = MFMA32(a0[s], qf[s], s0); s1 = MFMA32(a1[s], qf[s], s1); }
  }
}
DI bf16x8 packp(const f32x16& s, int s2) {
  u32x4 u;
  if (s2 == 0) { u[0] = pack2(s[0], s[1]); u[1] = pack2(s[2], s[3]); u[2] = pack2(s[4], s[5]); u[3] = pack2(s[6], s[7]); }
  else { u[0] = pack2(s[8], s[9]); u[1] = pack2(s[10], s[11]); u[2] = pack2(s[12], s[13]); u[3] = pack2(s[14], s[15]); }
  return __builtin_bit_cast(bf16x8, u);
}
template <int DV>
DI void attn_pv(f32x16 (&O)[DV / 32], const f32x16& s0, const f32x16& s1, const u16* Vts, const int tid) {
  const int lane = tid & 63, lr = lane & 31, h = lane >> 5;
  bf16x8 pf[2][2];
  pf[0][0] = packp(s0, 0); pf[0][1] = packp(s0, 1); pf[1][0] = packp(s1, 0); pf[1][1] = packp(s1, 1);
#pragma unroll
  for (int db = 0; db < DV / 32; db++) {
    bf16x8 a[4];
#pragma unroll
    for (int q = 0; q < 4; q++) {
      const u16* vp = &Vts[(db * 32 + lr) * 68 + q * 16 + 4 * h];
      s16x4 lo = *(const s16x4*)vp, hi = *(const s16x4*)(vp + 8);
      a[q] = __builtin_shufflevector(lo, hi, 0, 1, 2, 3, 4, 5, 6, 7);
    }
    __builtin_amdgcn_sched_barrier(0);
#pragma unroll
    for (int q = 0; q < 4; q++) O[db] = MFMA32(a[q], pf[q >> 1][q & 1], O[db]);
  }
}
template <int DV, int KW, class MF>
DI void attn_tile(f32x16 (&O)[DV / 32], float& m, float& l, const bf16x8 (&qf)[4], const u16* Ks, int kcol, const u16* Vts, MF valid, const bool MASKED, const bool lane_on, const int tid) {
  const int lane = tid & 63, h = lane >> 5;
  f32x16 s0, s1;
  attn_qk<KW>(s0, s1, qf, Ks, kcol, tid);
  float mx = MINIT;
  if (MASKED) {
#pragma unroll
    for (int r = 0; r < 16; r++) {
      const int kl = crow(r, h);
      s0[r] = valid(kl) ? s0[r] : MASKV;
      s1[r] = valid(32 + kl) ? s1[r] : MASKV;
    }
  }
#pragma unroll
  for (int r = 0; r < 16; r++) mx = fmaxf(mx, fmaxf(s0[r], s1[r]));
  mx = fmaxf(mx, __shfl_xor(mx, 32)) * SCL2;
  const bool need = lane_on && (mx > m + 8.f);
  const float mn = need ? mx : m;
  if (__any(need)) {
    const float alpha = ex2(m - mn);
    l *= alpha;
#pragma unroll
    for (int db = 0; db < DV / 32; db++)
#pragma unroll
      for (int r = 0; r < 16; r++) O[db][r] *= alpha;
  }
  m = mn;
  const float msub = lane_on ? mn : 3.0e38f;
  float ls = 0.f;
#pragma unroll
  for (int r = 0; r < 16; r++) { s0[r] = ex2(fmaf(s0[r], SCL2, -msub)); s1[r] = ex2(fmaf(s1[r], SCL2, -msub)); ls += s0[r] + s1[r]; }
  l += ls;
  attn_pv<DV>(O, s0, s1, Vts, tid);
}
template <int DV, int KW, class MF, class TM, class LO>
DI void attn_run(f32x16 (&O)[DV / 32], float& m, float& l, const bf16x8 (&qf)[4], int kcol, const u16* Kb, int ldk, const u16* Vb, size_t ldv, u64 tiles, MF mf, TM tmask, LO lon, u16* Ks, u16* Vts, const int tid) {
  u32x4 kr[KW / 32], vr[DV / 32];
  if (!tiles) return;
  attn_gload<DV, KW>(kr, vr, Kb, ldk, Vb, ldv, __builtin_ctzll(tiles) * 64, tid);
  while (tiles) {
    const int kt = __builtin_amdgcn_readfirstlane(__builtin_ctzll(tiles));
    tiles &= tiles - 1;
    __syncthreads();
    attn_sstore<DV, KW>(kr, vr, Ks, Vts, tid);
    __syncthreads();
    if (tiles) attn_gload<DV, KW>(kr, vr, Kb, ldk, Vb, ldv, __builtin_ctzll(tiles) * 64, tid);
    attn_tile<DV, KW>(O, m, l, qf, Ks, kcol, Vts, [&](int kl) { return mf(kt, kl); }, tmask(kt), lon(kt), tid);
  }
}

DI void phaseA_item(const Params& p, int layer, int item, u8* smem, float lam, float lam_init) {
  const int tid = otid(), lane = tid & 63, w = __builtin_amdgcn_readfirstlane(tid >> 6), lr = lane & 31, h = lane >> 5;
  const int qt = 63 - (item >> 4), bh = item & 15, b = bh >> 2, hd = bh & 3;
  const int comp = w & 1, th = w >> 1;
  const int t = qt * 64 + th * 32 + lr;
  const size_t grow = (size_t)b * S + t;
  u16* Ks = (u16*)smem; u16* Vts = (u16*)(smem + 64 * 136 * 2);
  const u16* aq = (const u16*)(p.ws + WS_AQ);
  const u16* ak = (const u16*)(p.ws + WS_AK) + (size_t)b * S * 512 + hd * 128;
  const u16* avt = (const u16*)(p.ws + WS_AVT) + (size_t)(hd * 128) * T + (size_t)b * S;
  bf16x8 qf[4];
#pragma unroll
  for (int s = 0; s < 4; s++) qf[s] = *(const bf16x8*)(aq + grow * 512 + hd * 128 + comp * 64 + s * 16 + h * 8);
  f32x16 O[4];
#pragma unroll
  for (int db = 0; db < 4; db++)
#pragma unroll
    for (int r = 0; r < 16; r++) O[db][r] = 0.f;
  float m = MINIT, l = 0.f;
  const u64 tiles = (qt == 63) ? ~0ull : ((1ull << (qt + 1)) - 1ull);
  attn_run<128, 128>(O, m, l, qf, comp * 64, ak, 512, avt, (size_t)T, tiles, [&](int kt, int kl) { return kt * 64 + kl <= t; }, [&](int kt) { return kt == qt; }, [&](int kt) { return true; }, Ks, Vts, tid);
  l += __shfl_xor(l, 32);
  const float il = 1.f / l;
  __syncthreads();
  float* ex = (float*)smem;
  if (comp == 1) {
#pragma unroll
    for (int db = 0; db < 4; db++)
#pragma unroll
      for (int r = 0; r < 16; r++) ex[(th * 128 + db * 32 + crow(r, h)) * 32 + lr] = O[db][r] * il;
  }
  __syncthreads();
  if (comp == 0) {
    float ss = 0.f;
#pragma unroll
    for (int db = 0; db < 4; db++)
#pragma unroll
      for (int r = 0; r < 16; r++) {
        float v = O[db][r] * il - lam * ex[(th * 128 + db * 32 + crow(r, h)) * 32 + lr];
        O[db][r] = v; ss += v * v;
      }
    ss += __shfl_xor(ss, 32);
    const float rn = rsqrtf(ss * (1.f / 128.f) + 1e-6f) * (1.f - lam_init);
    const float* sg = p.dsub + layer * 128;
    u16* Ob = (u16*)(p.ws + WS_O) + grow * OW + hd * 128;
#pragma unroll
    for (int db = 0; db < 4; db++)
#pragma unroll
      for (int g = 0; g < 4; g++) {
        int d0 = db * 32 + 8 * g + 4 * h;
        u32x2 o;
        o.x = pack2(O[db][4 * g] * rn * sg[d0], O[db][4 * g + 1] * rn * sg[d0 + 1]);
        o.y = pack2(O[db][4 * g + 2] * rn * sg[d0 + 2], O[db][4 * g + 3] * rn * sg[d0 + 3]);
        *(u32x2*)(Ob + d0) = o;
      }
  }
}

DI unsigned ordkey(float v) { unsigned u = __float_as_uint(v); return (u & 0x80000000u) ? ~u : (u | 0x80000000u); }

DI void phaseB_item(const Params& p, int item, u8* smem) {
  const int tid = otid(), lane = tid & 63, w = __builtin_amdgcn_readfirstlane(tid >> 6), lr = lane & 31, h = lane >> 5;
  const int b = item & 3, t0 = (1023 - (item >> 2)) * 4;
  unsigned* sc = (unsigned*)smem;
  const int nk = t0 + 4, ntile = (nk + 31) >> 5;
  const u16* iq = (const u16*)(p.ws + WS_IQ);
  const u16* ik = (const u16*)(p.ws + WS_IK) + (size_t)b * S * 64;
  const float* misc = (const float*)(p.ws + WS_MISC);
  {
    bf16x8 af[4];
    const int qi_a = lr >> 3, hd_a = lr & 7;
#pragma unroll
    for (int s = 0; s < 4; s++) af[s] = *(const bf16x8*)(iq + ((size_t)b * S + t0 + qi_a) * 512 + hd_a * 64 + s * 16 + h * 8);
    float wt[4][4];
#pragma unroll
    for (int qi = 0; qi < 4; qi++)
#pragma unroll
      for (int j = 0; j < 4; j++) wt[qi][j] = misc[((size_t)b * S + t0 + qi) * 32 + 4 * h + j] * (0.35355339059327373f * 0.125f);
    for (int kt = w; kt < ntile; kt += 16) {
      int ktv[4];
      bf16x8 bfr[4][4];
#pragma unroll
      for (int u = 0; u < 4; u++) {
        ktv[u] = (kt + 4 * u < ntile) ? kt + 4 * u : kt;
        const u16* kp = ik + (size_t)(ktv[u] * 32 + lr) * 64 + h * 8;
#pragma unroll
        for (int s = 0; s < 4; s++) bfr[u][s] = *(const bf16x8*)(kp + s * 16);
      }
#pragma unroll
      for (int u = 0; u < 4; u++) {
        f32x16 acc;
#pragma unroll
        for (int r = 0; r < 16; r++) acc[r] = 0.f;
#pragma unroll
        for (int s = 0; s < 4; s++) acc = MFMA32(af[s], bfr[u][s], acc);
        const int key = ktv[u] * 32 + lr;
#pragma unroll
        for (int qi = 0; qi < 4; qi++) {
          float v = wt[qi][0] * fmaxf(acc[qi * 4], 0.f) + wt[qi][1] * fmaxf(acc[qi * 4 + 1], 0.f) + wt[qi][2] * fmaxf(acc[qi * 4 + 2], 0.f) + wt[qi][3] * fmaxf(acc[qi * 4 + 3], 0.f);
          v += __shfl_xor(v, 32);
          const unsigned uu = (key <= t0 + qi) ? ordkey(v) : 0u;
          if ((qi >> 1) == h) sc[qi * 4096 + key] = uu;
        }
      }
    }
  }
  __syncthreads();
  const int t = t0 + w, n = t + 1;
  unsigned* row = sc + w * 4096;
  u16* list = (u16*)row;
  float* P = (float*)(row + 1024);
  int cnt;
  if (n <= 256) {
    cnt = n;
#pragma unroll
    for (int i = 0; i < 4; i++) { int sl = lane + 64 * i; list[sl] = (u16)(sl < n ? sl : 0); }
  } else {
    cnt = 256;
    unsigned kreg[64];
#pragma unroll
    for (int i = 0; i < 64; i++) {
      unsigned v = 0u;
      if (i * 64 < n) { int k = i * 64 + lane; v = (k <= t) ? row[k] : 0u; }
      kreg[i] = v;
    }
    const int ngrp = (n + 511) >> 9;
    unsigned Tv = 0u;
#pragma unroll 1
    for (int bit = 31; bit >= 24; --bit) {
      const unsigned cand = Tv | (1u << bit);
      int c = 0;
#pragma unroll
      for (int g = 0; g < 8; g++)
        if (g < ngrp) {
#pragma unroll
          for (int j = 0; j < 8; j++) c += (kreg[g * 8 + j] >= cand) ? 1 : 0;
        }
      c = wsum_dpp(c);
      if (c >= 256) Tv = cand;
    }
    int need = 256;
    if (Tv < 0xff000000u) {
      const unsigned up = Tv + (1u << 24);
      int c = 0;
#pragma unroll
      for (int g = 0; g < 8; g++)
        if (g < ngrp) {
#pragma unroll
          for (int j = 0; j < 8; j++) c += (kreg[g * 8 + j] >= up) ? 1 : 0;
        }
      need = 256 - wsum_dpp(c);
    }
    unsigned* hist = row + 3072;
    unsigned prefix = Tv >> 24;
#pragma unroll 1
    for (int shift = 16; shift >= 0; shift -= 8) {
      { u32x4 z = {0u, 0u, 0u, 0u}; ((u32x4*)hist)[lane] = z; }
      __builtin_amdgcn_fence(__ATOMIC_RELEASE, "workgroup");
#pragma unroll
      for (int g = 0; g < 8; g++)
        if (g < ngrp) {
#pragma unroll
          for (int j = 0; j < 8; j++) {
            const unsigned k = kreg[g * 8 + j];
            if ((k >> (shift + 8)) == prefix) __hip_atomic_fetch_add(&hist[(k >> shift) & 255u], 1u, __ATOMIC_RELAXED, __HIP_MEMORY_SCOPE_WORKGROUP);
          }
          __builtin_amdgcn_sched_barrier(0);
        }
      __builtin_amdgcn_fence(__ATOMIC_ACQ_REL, "workgroup");
      const u32x4 cb = ((const u32x4*)hist)[63 - lane];
      const int c3 = (int)cb.w, c2 = (int)cb.z, c1 = (int)cb.y, c0 = (int)cb.x;
      const int ssum = (c3 + c2) + (c1 + c0);
      const int P = wscan_dpp(ssum);
      const u64 bal = __ballot(P >= need);
      const int L = __builtin_ctzll(bal);
      int accu = P - ssum;
      int binl, ndl;
      const int top = 255 - 4 * lane;
      if (accu + c3 >= need) { binl = top; ndl = need - accu; }
      else {
        accu += c3;
        if (accu + c2 >= need) { binl = top - 1; ndl = need - accu; }
        else {
          accu += c2;
          if (accu + c1 >= need) { binl = top - 2; ndl = need - accu; }
          else { accu += c1; binl = top - 3; ndl = need - accu; }
        }
      }
      const int bin = __builtin_amdgcn_readlane(binl, L);
      need = __builtin_amdgcn_readlane(ndl, L);
      prefix = (prefix << 8) | (unsigned)bin;
    }
    Tv = prefix;
    int base = 0, eqs = 0;
#pragma unroll
    for (int g = 0; g < 8; g++)
      if (g < ngrp) {
#pragma unroll
        for (int j = 0; j < 8; j++) {
          const int i = g * 8 + j;
          const bool gt = kreg[i] > Tv, eq = kreg[i] == Tv;
          const u64 beq = __ballot(eq);
          const int erank = eqs + mbcnt(beq);
          const bool sel = gt || (eq && erank < need);
          const u64 bs = __ballot(sel);
          if (sel) list[base + mbcnt(bs)] = (u16)(i * 64 + lane);
          base += __popcll(bs); eqs += __popcll(beq);
        }
      }
  }
  const u16* bk = (const u16*)(p.ws + WS_BK) + (size_t)b * S * 64;
  const u16* bv = (const u16*)(p.ws + WS_BV) + (size_t)b * S * 64;
  {
    const u16* bq = (const u16*)(p.ws + WS_BQ) + ((size_t)b * S + t) * 512;
    bf16x8 qb[4];
#pragma unroll
    for (int s = 0; s < 4; s++) {
      bf16x8 z = {0, 0, 0, 0, 0, 0, 0, 0};
      qb[s] = (lr < 8) ? *(const bf16x8*)(bq + lr * 64 + s * 16 + h * 8) : z;
    }
#pragma unroll 2
    for (int kb2 = 0; kb2 < 2; kb2++) {
      bf16x8 ka[4][4];
#pragma unroll
      for (int q4 = 0; q4 < 4; q4++) {
        const int kidx = list[(kb2 * 4 + q4) * 32 + lr];
#pragma unroll
        for (int s = 0; s < 4; s++) ka[q4][s] = *(const bf16x8*)(bk + (size_t)kidx * 64 + s * 16 + h * 8);
      }
#pragma unroll
      for (int q4 = 0; q4 < 4; q4++) {
        f32x16 acc;
#pragma unroll
        for (int r = 0; r < 16; r++) acc[r] = 0.f;
#pragma unroll
        for (int s = 0; s < 4; s++) acc = MFMA32(ka[q4][s], qb[s], acc);
        if (lr < 8) {
#pragma unroll
          for (int r = 0; r < 16; r++) P[((kb2 * 4 + q4) * 32 + crow(r, h)) * 8 + lr] = acc[r] * SCL2;
        }
      }
    }
  }
  {
    f32x4 pa[4], pb[4];
#pragma unroll
    for (int i = 0; i < 4; i++) { const int sl = lane + 64 * i; pa[i] = *(const f32x4*)&P[sl * 8]; pb[i] = *(const f32x4*)&P[sl * 8 + 4]; }
#pragma unroll
    for (int hd = 0; hd < 8; hd++) {
      float sv[4];
      float mx = MASKV;
#pragma unroll
      for (int i = 0; i < 4; i++) {
        const bool ok = (lane + 64 * i) < cnt;
        float x = (hd < 4) ? pa[i][hd & 3] : pb[i][hd & 3];
        sv[i] = ok ? x : MASKV; mx = fmaxf(mx, sv[i]);
      }
      mx = wmaxf(mx);
      float sm = 0.f;
#pragma unroll
      for (int i = 0; i < 4; i++) { sv[i] = ex2(sv[i] - mx); sm += sv[i]; }
      sm = wsum(sm);
      const float is = 1.f / sm;
#pragma unroll
      for (int i = 0; i < 4; i++) { if (hd < 4) pa[i][hd & 3] = sv[i] * is; else pb[i][hd & 3] = sv[i] * is; }
    }
#pragma unroll
    for (int i = 0; i < 4; i++) { const int sl = lane + 64 * i; *(f32x4*)&P[sl * 8] = pa[i]; *(f32x4*)&P[sl * 8 + 4] = pb[i]; }
  }
  {
    const int kg = lane >> 3, dc = lane & 7;
    float acc[8][8];
#pragma unroll
    for (int hd = 0; hd < 8; hd++)
#pragma unroll
      for (int j = 0; j < 8; j++) acc[hd][j] = 0.f;
    const int nit = (cnt + 7) >> 3;
    const int nb = (nit + 3) >> 2;
    u32x4 vcur[4], vnxt[4];
#pragma unroll
    for (int u = 0; u < 4; u++) {
      const int kidx = list[u * 8 + kg];
      vcur[u] = *(const u32x4*)(bv + (size_t)kidx * 64 + dc * 8);
    }
#pragma unroll 1
    for (int bt = 0; bt < nb; bt++) {
      if (bt + 1 < nb) {
#pragma unroll
        for (int u = 0; u < 4; u++) {
          const int kidx = list[(bt + 1) * 32 + u * 8 + kg];
          vnxt[u] = *(const u32x4*)(bv + (size_t)kidx * 64 + dc * 8);
        }
      }
#pragma unroll
      for (int u = 0; u < 4; u++) {
        const int slot = bt * 32 + u * 8 + kg;
        const f32x4 qa = *(const f32x4*)&P[slot * 8], qb2 = *(const f32x4*)&P[slot * 8 + 4];
        const u32x4 vv = vcur[u];
        float vf[8];
        vf[0] = bflo(vv.x); vf[1] = bfhi(vv.x); vf[2] = bflo(vv.y); vf[3] = bfhi(vv.y);
        vf[4] = bflo(vv.z); vf[5] = bfhi(vv.z); vf[6] = bflo(vv.w); vf[7] = bfhi(vv.w);
#pragma unroll
        for (int j = 0; j < 8; j++) {
          acc[0][j] += qa.x * vf[j]; acc[1][j] += qa.y * vf[j]; acc[2][j] += qa.z * vf[j]; acc[3][j] += qa.w * vf[j];
          acc[4][j] += qb2.x * vf[j]; acc[5][j] += qb2.y * vf[j]; acc[6][j] += qb2.z * vf[j]; acc[7][j] += qb2.w * vf[j];
        }
      }
#pragma unroll
      for (int u = 0; u < 4; u++) vcur[u] = vnxt[u];
    }
    const bool b5 = (lane & 32) != 0, b4 = (lane & 16) != 0, b3 = (lane & 8) != 0;
    float a1[4][8], a2[2][8], a3[8];
#pragma unroll
    for (int hd = 0; hd < 4; hd++)
#pragma unroll
      for (int j = 0; j < 8; j++) {
        float send = b5 ? acc[hd][j] : acc[hd + 4][j];
        float keep = b5 ? acc[hd + 4][j] : acc[hd][j];
        a1[hd][j] = keep + __shfl_xor(send, 32);
      }
#pragma unroll
    for (int hd = 0; hd < 2; hd++)
#pragma unroll
      for (int j = 0; j < 8; j++) {
        float send = b4 ? a1[hd][j] : a1[hd + 2][j];
        float keep = b4 ? a1[hd + 2][j] : a1[hd][j];
        a2[hd][j] = keep + __shfl_xor(send, 16);
      }
#pragma unroll
    for (int j = 0; j < 8; j++) {
      float send = b3 ? a2[0][j] : a2[1][j];
      float keep = b3 ? a2[1][j] : a2[0][j];
      a3[j] = keep + __shfl_xor(send, 8);
    }
    u32x4 o;
    o.x = pack2(a3[0], a3[1]); o.y = pack2(a3[2], a3[3]); o.z = pack2(a3[4], a3[5]); o.w = pack2(a3[6], a3[7]);
    u16* Ob = (u16*)(p.ws + WS_O) + ((size_t)b * S + t) * OW + 512;
    *(u32x4*)(Ob + kg * 64 + dc * 8) = o;
  }
}

DI float gelu_tanh(float x) {
  float u = 0.7978845608028654f * (x + 0.044715f * x * x * x);
  float th = 1.f - 2.f / (1.f + __expf(2.f * u));
  return 0.5f * x * (1.f + th);
}
DI void phaseCmp_item(const Params& p, int layer, int item, u8* smem) {
  const int tid = otid(), lane = tid & 63, w = __builtin_amdgcn_readfirstlane(tid >> 6), lr = lane & 31, h = lane >> 5;
  const int kv = item >> 6, rt = item & 63, bg = rt >> 3, n0 = (rt & 7) * 32, b = bg >> 1, g = bg & 1;
  const u16* src = (const u16*)(p.ws + (kv ? WS_CVC : WS_CKC));
  const float* pe = (kv ? p.pe_v : p.pe_k) + (size_t)layer * 32 * 64;
  const u16* w1 = (const u16*)(p.ws + WS_CW1) + (size_t)kv * 128 * 2048;
  const u16* w2 = (const u16*)(p.ws + WS_CW2) + (size_t)kv * 64 * 128;
  u16* hid = (u16*)smem;
  const int n = n0 + lr;
  f32x16 acc;
#pragma unroll
  for (int r = 0; r < 16; r++) acc[r] = 0.f;
  const u16* w1p = w1 + (size_t)(32 * w + lr) * 2048 + h * 8;
#pragma unroll 4
  for (int s = 0; s < 128; s++) {
    const int lp = s >> 2, d0 = (s & 3) * 16 + h * 8;
    int tok = 16 * n + lp; if (tok > S - 1) tok = S - 1;
    u32x4 raw = *(const u32x4*)(src + ((size_t)b * S + tok) * 128 + g * 64 + d0);
    f32x4 pa = *(const f32x4*)(pe + lp * 64 + d0), pb = *(const f32x4*)(pe + lp * 64 + d0 + 4);
    u32x4 u;
    u[0] = pack2(bflo(raw.x) + pa.x, bfhi(raw.x) + pa.y); u[1] = pack2(bflo(raw.y) + pa.z, bfhi(raw.y) + pa.w);
    u[2] = pack2(bflo(raw.z) + pb.x, bfhi(raw.z) + pb.y); u[3] = pack2(bflo(raw.w) + pb.z, bfhi(raw.w) + pb.w);
    bf16x8 a = __builtin_bit_cast(bf16x8, u);
    bf16x8 bfr = *(const bf16x8*)(w1p + s * 16);
    acc = MFMA32(a, bfr, acc);
  }
  __syncthreads();
#pragma unroll
  for (int r = 0; r < 16; r++) hid[crow(r, h) * 136 + 32 * w + lr] = f2bf(gelu_tanh(acc[r]));
  __syncthreads();
  if (w < 2) {
    f32x16 o;
#pragma unroll
    for (int r = 0; r < 16; r++) o[r] = 0.f;
#pragma unroll
    for (int s = 0; s < 8; s++) {
      bf16x8 a = *(const bf16x8*)&hid[lr * 136 + s * 16 + h * 8];
      bf16x8 bfr = *(const bf16x8*)(w2 + (size_t)(32 * w + lr) * 128 + s * 16 + h * 8);
      o = MFMA32(a, bfr, o);
    }
    const int d = 32 * w + lr;
    if (kv == 0) {
      u16* kc = (u16*)(p.ws + WS_KC);
#pragma unroll
      for (int r = 0; r < 16; r++) { int nn = n0 + crow(r, h); kc[((size_t)bg * 256 + nn) * 64 + d] = (nn < 255) ? f2bf(o[r]) : (u16)0; }
    } else {
      u16* vct = (u16*)(p.ws + WS_VCT);
#pragma unroll
      for (int g4 = 0; g4 < 4; g4++) {
        int nn0 = n0 + 8 * g4 + 4 * h;
        float v3 = (nn0 + 3 < 255) ? o[4 * g4 + 3] : 0.f;
        u32x2 ov; ov.x = pack2(o[4 * g4], o[4 * g4 + 1]); ov.y = pack2(o[4 * g4 + 2], v3);
        *(u32x2*)(vct + ((size_t)bg * 64 + d) * 256 + nn0) = ov;
      }
    }
  }
}

DI void phaseC_item(const Params& p, int item, u8* smem) {
  const int tid = otid(), lane = tid & 63, w = __builtin_amdgcn_readfirstlane(tid >> 6), lr = lane & 31, h = lane >> 5;
  const int qt = 127 - (item >> 3), bg = item & 7, b = bg >> 1, g = bg & 1;
  const int q0 = qt * 32, t = q0 + lr, hh = g * 4 + w;
  const size_t grow = (size_t)b * S + t;
  u16* Ks = (u16*)smem; u16* Vts = (u16*)(smem + 9216);
  float* imp = (float*)(smem + 17920);
  u64* msk = (u64*)(smem + 50688);
  const float* cosT = (const float*)(p.ws + WS_COS);
  const float* sinT = (const float*)(p.ws + WS_SIN);
  const float* misc = (const float*)(p.ws + WS_MISC);
  bf16x8 qf[4], qr[4];
#pragma unroll
  for (int s = 0; s < 4; s++) { qf[s] = *(const bf16x8*)((const u16*)(p.ws + WS_CQ) + grow * 512 + hh * 64 + s * 16 + h * 8); qr[s] = qf[s]; }
  {
    u32x4 u;
    float rr[8];
#pragma unroll
    for (int j = 0; j < 8; j++) {
      float x = bf2f((u16)qf[0][j]);
      float o = __shfl_xor(x, 32);
      float cs = cosT[grow * 8 + j], sn = sinT[grow * 8 + j];
      rr[j] = (h == 0) ? (x * cs - o * sn) : (x * cs + o * sn);
    }
    u[0] = pack2(rr[0], rr[1]); u[1] = pack2(rr[2], rr[3]); u[2] = pack2(rr[4], rr[5]); u[3] = pack2(rr[6], rr[7]);
    qr[0] = __builtin_bit_cast(bf16x8, u);
  }
  __syncthreads();
  {
    f32x4 z; z.x = 0.f; z.y = 0.f; z.z = 0.f; z.w = 0.f;
#pragma unroll
    for (int i = 0; i < 8; i++) ((f32x4*)imp)[tid + 256 * i] = z;
  }
  f32x16 Ot[2];
#pragma unroll
  for (int db = 0; db < 2; db++)
#pragma unroll
    for (int r = 0; r < 16; r++) Ot[db][r] = 0.f;
  {
    const u16* Kc = (const u16*)(p.ws + WS_KC) + (size_t)bg * 256 * 64;
    const u16* Vc = (const u16*)(p.ws + WS_VCT) + (size_t)bg * 64 * 256;
    const int nct = ((q0 >> 4) >> 6) + 1;
    float mc = MINIT, lc = 0.f;
    u32x4 kr[2], vr[2];
    for (int kt = 0; kt < nct; kt++) {
      attn_gload<64, 64>(kr, vr, Kc, 64, Vc, 256, kt * 64, tid);
      __syncthreads();
      attn_sstore<64, 64>(kr, vr, Ks, Vts, tid);
      __syncthreads();
      f32x16 s0, s1;
      attn_qk<64>(s0, s1, qf, Ks, 0, tid);
      float mx = MINIT;
#pragma unroll
      for (int r = 0; r < 16; r++) {
        int n0 = kt * 64 + crow(r, h), n1 = n0 + 32;
        s0[r] = (16 * n0 + 31 <= t) ? s0[r] * SCL2 : MASKV;
        s1[r] = (16 * n1 + 31 <= t) ? s1[r] * SCL2 : MASKV;
        mx = fmaxf(mx, fmaxf(s0[r], s1[r]));
      }
      mx = fmaxf(mx, __shfl_xor(mx, 32));
      const float mn = fmaxf(mc, mx);
      float ls = 0.f;
#pragma unroll
      for (int r = 0; r < 16; r++) ls += ex2(s0[r] - mn) + ex2(s1[r] - mn);
      lc = lc * ex2(mc - mn) + ls;
      mc = mn;
    }
    lc += __shfl_xor(lc, 32);
    const float ilc = (lc > 0.f) ? 1.f / lc : 0.f;
    float xprev = 0.f;
    f32x16 Oc[2];
#pragma unroll
    for (int db = 0; db < 2; db++)
#pragma unroll
      for (int r = 0; r < 16; r++) Oc[db][r] = 0.f;
    for (int kt = 0; kt < nct; kt++) {
      attn_gload<64, 64>(kr, vr, Kc, 64, Vc, 256, kt * 64, tid);
      __syncthreads();
      attn_sstore<64, 64>(kr, vr, Ks, Vts, tid);
      __syncthreads();
      f32x16 s0, s1;
      attn_qk<64>(s0, s1, qf, Ks, 0, tid);
#pragma unroll
      for (int r = 0; r < 16; r++) {
        int n0 = kt * 64 + crow(r, h), n1 = n0 + 32;
        s0[r] = (16 * n0 + 31 <= t) ? ex2(s0[r] * SCL2 - mc) * ilc : 0.f;
        s1[r] = (16 * n1 + 31 <= t) ? ex2(s1[r] * SCL2 - mc) * ilc : 0.f;
      }
#pragma unroll
      for (int g4 = 0; g4 < 4; g4++) {
        float G = s0[4 * g4] + s0[4 * g4 + 1] + s0[4 * g4 + 2] + s0[4 * g4 + 3];
        float X = __shfl_xor(s0[4 * g4 + 3], 32);
        float val = G + (h ? X : xprev);
        xprev = X;
        imp[(w * 32 + lr) * 64 + kt * 16 + 2 * g4 + h] = val;
      }
#pragma unroll
      for (int g4 = 0; g4 < 4; g4++) {
        float G = s1[4 * g4] + s1[4 * g4 + 1] + s1[4 * g4 + 2] + s1[4 * g4 + 3];
        float X = __shfl_xor(s1[4 * g4 + 3], 32);
        float val = G + (h ? X : xprev);
        xprev = X;
        imp[(w * 32 + lr) * 64 + kt * 16 + 8 + 2 * g4 + h] = val;
      }
      attn_pv<64>(Oc, s0, s1, Vts, tid);
    }
    if (nct < 4 && h == 0) imp[(w * 32 + lr) * 64 + nct * 16] = xprev;
    const float g0 = sigm(misc[grow * 32 + 8 + hh * 3 + 0]);
#pragma unroll
    for (int db = 0; db < 2; db++)
#pragma unroll
      for (int r = 0; r < 16; r++) Ot[db][r] = g0 * Oc[db][r];
  }
  __syncthreads();
  {
#pragma unroll 1
    for (int i = 0; i < 8; i++) {
      const int tok = w * 8 + i, tt = q0 + tok;
      float v = imp[(0 * 32 + tok) * 64 + lane] + imp[(1 * 32 + tok) * 64 + lane];
      v += imp[(2 * 32 + tok) * 64 + lane];
      v += imp[(3 * 32 + tok) * 64 + lane];
      if (lane == (tt >> 6) || lane == 0) v = 1.0e4f;
      if (lane * 64 > tt) v = -INFINITY;
      int rank = 0;
#pragma unroll 8
      for (int mm = 0; mm < 64; mm++) { float o = __shfl(v, mm); rank += ((o > v) || (o == v && mm < lane)) ? 1 : 0; }
      const u64 bm = __ballot(rank < 16);
      if (lane == 0) msk[tok] = bm;
    }
  }
  __syncthreads();
  float* park = imp + (w * 32) * 64 + lane;
#pragma unroll
  for (int db = 0; db < 2; db++)
#pragma unroll
    for (int r = 0; r < 16; r++) park[(db * 16 + r) * 64] = Ot[db][r];
  {
    const u64 mymask = msk[lr];
    unsigned lo = (unsigned)mymask, hi = (unsigned)(mymask >> 32);
    for (int o = 16; o; o >>= 1) { lo |= __shfl_xor(lo, o); hi |= __shfl_xor(hi, o); }
    lo |= __shfl_xor(lo, 32); hi |= __shfl_xor(hi, 32);
    u64 um = ((u64)hi << 32) | lo;
    const int nkt = ((q0 + 31) >> 6) + 1;
    if (nkt < 64) um &= ((1ull << nkt) - 1ull);
    f32x16 Os[2];
#pragma unroll
    for (int db = 0; db < 2; db++)
#pragma unroll
      for (int r = 0; r < 16; r++) Os[db][r] = 0.f;
    float ms = MINIT, ls = 0.f;
    const u16* Kb = (const u16*)(p.ws + WS_CKS) + (size_t)b * S * 128 + g * 64;
    const u16* Vb = (const u16*)(p.ws + WS_CVST) + (size_t)(g * 64) * T + (size_t)b * S;
    attn_run<64, 64>(Os, ms, ls, qr, 0, Kb, 128, Vb, (size_t)T, um,
                     [&](int kt, int kl) { return kt * 64 + kl <= t; }, [&](int kt) { return kt == (q0 >> 6); }, [&](int kt) { return ((mymask >> kt) & 1ull) != 0ull; }, Ks, Vts, tid);
    ls += __shfl_xor(ls, 32);
    const float g1 = sigm(misc[grow * 32 + 8 + hh * 3 + 1]) / ls;
#pragma unroll
    for (int db = 0; db < 2; db++)
#pragma unroll
      for (int r = 0; r < 16; r++) park[(db * 16 + r) * 64] += g1 * Os[db][r];
  }
  {
    int lo_t = q0 - 511; if (lo_t < 0) lo_t = 0;
    const int kt0 = lo_t >> 6, kt1 = (q0 + 31) >> 6;
    u64 tiles = (kt1 == 63) ? ~0ull : ((1ull << (kt1 + 1)) - 1ull);
    tiles &= ~((1ull << kt0) - 1ull);
    f32x16 Ow[2];
#pragma unroll
    for (int db = 0; db < 2; db++)
#pragma unroll
      for (int r = 0; r < 16; r++) Ow[db][r] = 0.f;
    float mw = MINIT, lw = 0.f;
    const u16* Kb = (const u16*)(p.ws + WS_CKW) + (size_t)b * S * 128 + g * 64;
    const u16* Vb = (const u16*)(p.ws + WS_CVWT) + (size_t)(g * 64) * T + (size_t)b * S;
    attn_run<64, 64>(Ow, mw, lw, qr, 0, Kb, 128, Vb, (size_t)T, tiles,
                     [&](int kt, int kl) { int key = kt * 64 + kl; return (key <= t) && (key > t - 512); }, [&](int kt) { return !((kt * 64 + 63 <= q0) && (kt * 64 > q0 + 31 - 512)); }, [&](int kt) { return true; }, Ks, Vts, tid);
    lw += __shfl_xor(lw, 32);
    const float g2 = sigm(misc[grow * 32 + 8 + hh * 3 + 2]) / lw;
#pragma unroll
    for (int db = 0; db < 2; db++)
#pragma unroll
      for (int r = 0; r < 16; r++) Ot[db][r] = park[(db * 16 + r) * 64] + g2 * Ow[db][r];
  }
  u16* Ob = (u16*)(p.ws + WS_O) + grow * OW + 1024 + hh * 64;
#pragma unroll
  for (int db = 0; db < 2; db++)
#pragma unroll
    for (int g4 = 0; g4 < 4; g4++) {
      int d0 = db * 32 + 8 * g4 + 4 * h;
      u32x2 o; o.x = pack2(Ot[db][4 * g4], Ot[db][4 * g4 + 1]); o.y = pack2(Ot[db][4 * g4 + 2], Ot[db][4 * g4 + 3]);
      *(u32x2*)(Ob + d0) = o;
    }
}

DI int fetch_item(int* ctr, u8* smem) {
  volatile int* mbox = (volatile int*)smem;
  __syncthreads();
  if (threadIdx.x == 0) *mbox = atomicAdd(ctr, 1);
  __syncthreads();
  int it = __builtin_amdgcn_readfirstlane(*mbox);
  __syncthreads();
  return it;
}

constexpr int XB_CNT = 0, XB_SUB = 1024, XB_GEN = 2048, XB_TOP = 3072, XB_TOPGEN = 3136;
DI unsigned xb_ld(unsigned* p) { return __hip_atomic_load(p, __ATOMIC_RELAXED, __HIP_MEMORY_SCOPE_AGENT); }
DI unsigned xb_add(unsigned* p, unsigned v) { return __hip_atomic_fetch_add(p, v, __ATOMIC_RELAXED, __HIP_MEMORY_SCOPE_AGENT); }
DI unsigned xcc_id() { return (unsigned)__builtin_amdgcn_s_getreg((3 << 11) | 20) & 0xFu; }
struct GridBar { unsigned* bar; unsigned x, nloc, nx, k; };
DI void grid_barrier(GridBar& b) {
  asm volatile("s_waitcnt vmcnt(0)" ::: "memory");
  __syncthreads();
  if (threadIdx.x == 0) {
    unsigned* bar = b.bar;
    const unsigned k = ++b.k;
    if (b.nloc == 0u) {
      const unsigned G = gridDim.x;
      for (;;) {
        unsigned sum = 0u, cnt = 0u, mine = 0u;
#pragma unroll
        for (unsigned j = 0; j < 16; ++j) { const unsigned c = xb_ld(bar + XB_CNT + 64 * j); sum += c; cnt += (c > 0u) ? 1u : 0u; mine = (j == b.x) ? c : mine; }
        if (sum == G) { b.nloc = mine; b.nx = cnt; break; }
        __builtin_amdgcn_s_sleep(1);
      }
    }
    const unsigned old = xb_add(bar + XB_SUB + 64 * b.x, 1u);
    if (old + 1u == k * b.nloc) {
      __builtin_amdgcn_fence(__ATOMIC_RELEASE, "agent");
      asm volatile("s_waitcnt vmcnt(0)" ::: "memory");
      const unsigned og = xb_add(bar + XB_TOP, 1u);
      if (og + 1u == k * b.nx) xb_add(bar + XB_TOPGEN, 1u);
      else while (xb_ld(bar + XB_TOPGEN) < k) __builtin_amdgcn_s_sleep(1);
      __builtin_amdgcn_fence(__ATOMIC_ACQUIRE, "agent");
      xb_add(bar + XB_GEN + 64 * b.x, 1u);
      asm volatile("s_waitcnt vmcnt(0)" ::: "memory");
    } else {
      while (xb_ld(bar + XB_GEN + 64 * b.x) < k) __builtin_amdgcn_s_sleep(1);
      __builtin_amdgcn_fence(__ATOMIC_ACQUIRE, "agent");
      asm volatile("s_waitcnt vmcnt(0)" ::: "memory");
    }
  }
  __syncthreads();
}

__global__ void __launch_bounds__(256, 2) fwd_megakernel(Params p) {
  cg::grid_group grid = cg::this_grid();
  __shared__ __attribute__((aligned(16))) u8 smem[65536];
  u8* ws = p.ws;
  int* ctr = (int*)(ws + WS_CTR);
  GridBar gb; gb.bar = (unsigned*)(ws + WS_BAR); gb.x = xcc_id(); gb.nloc = 0u; gb.nx = 0u; gb.k = 0u;
  if (threadIdx.x == 0) (void)xb_add(gb.bar + XB_CNT + 64 * gb.x, 1u);
  rope_tables(p);
  prep_layer(p, 0, smem);
  norm_rows(p.x, (u16*)(ws + WS_XB), (float*)(ws + WS_PART0));
  if (p.out == nullptr) grid.sync();
  grid_barrier(gb);
#pragma unroll 1
  for (int layer = 0; layer < NL; layer++) {
    if (layer > 0) prep_layer(p, layer, smem, 0x0180u);
    phase_gemm1(p, smem);
    grid_barrier(gb);
    {
      const float lam_init = 0.8f - 0.6f * __expf(-0.3f * (float)layer);
      const float* lp = p.dlam + layer * 256;
      const int lane = otid() & 63;
      float s1 = wsum(lp[lane] * lp[64 + lane]);
      float s2 = wsum(lp[128 + lane] * lp[192 + lane]);
      const float lam = __expf(s1) - __expf(s2) + lam_init;
      unsigned acq_mask = 0u;
#pragma unroll 1
      for (int dq = 0; dq < 8; dq++) {
        const int q = (int)((gb.x + (unsigned)dq) & 7u);
        int* qctr = ctr + layer * 8 + q;
        int* cdone = ctr + 16 + layer * 8 + q;
        for (;;) {
          const int i = fetch_item(qctr, smem);
          if (i >= 16 + 384 + 384) break;
          if (i < 16) {
            phaseCmp_item(p, layer, (i >> 3) * 64 + q * 8 + (i & 7), smem);
            __syncthreads();
            if (threadIdx.x == 0) { __threadfence(); atomicAdd(cdone, 1); }
          } else {
            const int u = i - 16;
            const int half = (u >= 384) ? 1 : 0;
            const int u2 = u - half * 384;
            const int g = u2 / 3, r = u2 - g * 3;
            if (r != 0) {
              const int gbl = half * 256 + g * 2 + (r - 1);
              phaseB_item(p, (2 * gbl + (q >> 2)) * 4 + (q & 3), smem);
            } else if (half == 0) {
              phaseA_item(p, layer, (g >> 1) * 16 + 2 * q + (g & 1), smem, lam, lam_init);
            } else {
              if (!((acq_mask >> q) & 1u)) {
                if (threadIdx.x == 0) {
                  while (__hip_atomic_load(cdone, __ATOMIC_RELAXED, __HIP_MEMORY_SCOPE_AGENT) < 16) __builtin_amdgcn_s_sleep(8);
                  __threadfence();
                }
                __syncthreads();
                __builtin_amdgcn_fence(__ATOMIC_ACQUIRE, "agent");
                acq_mask |= 1u << q;
              }
              phaseC_item(p, g * 8 + q, smem);
            }
          }
        }
      }
    }
    grid_barrier(gb);
    phase_gates(p, smem);
    grid_barrier(gb);
    phase_mix(p, smem);
    grid_barrier(gb);
    convert_p(p.p + (size_t)layer * T * PLE, (u16*)(ws + WS_PB));
    phase_outproj(p, layer == 0 ? p.x : p.out, smem);
    grid_barrier(gb);
    if (layer + 1 < NL) prep_layer(p, layer + 1, smem, 0x1fffu & ~0x0180u);
    phase_ple(p, smem);
    grid_barrier(gb);
    if (layer + 1 == NL) {
      final_norm(p.out, p.fin_g, (const float*)(ws + WS_PART0));
    }
  }
}

extern "C" void kernel_launch(void* const* d_in, const int* in_sizes, int n_in, void* d_out, int out_size,
                              void* d_ws, size_t ws_size, hipStream_t stream) {
  static int grid_blocks = 0;
  if (!grid_blocks) {
    int dev = 0, cus = 0, per_cu = 0;
    (void)hipGetDevice(&dev);
    (void)hipDeviceGetAttribute(&cus, hipDeviceAttributeMultiprocessorCount, dev);
    (void)hipOccupancyMaxActiveBlocksPerMultiprocessor(&per_cu, fwd_megakernel, 256, 0);
    if (per_cu > 2) per_cu = 2;
    if (per_cu < 1) per_cu = 1;
    grid_blocks = cus * per_cu;
    if (ws_size < WS_END) fprintf(stderr, "kernel_launch: workspace too small: %zu < %zu\n", ws_size, (size_t)WS_END);
  }
  Params p{};
  p.x = (const float*)d_in[0]; p.p = (const float*)d_in[1]; p.pos = (const int*)d_in[2];
  p.norm_g = (const float*)d_in[3]; p.w_in = (const float*)d_in[4]; p.dlam = (const float*)d_in[5]; p.dsub = (const float*)d_in[6];
  p.pe_k = (const float*)d_in[7]; p.w1_k = (const float*)d_in[8]; p.w2_k = (const float*)d_in[9];
  p.pe_v = (const float*)d_in[10]; p.w1_v = (const float*)d_in[11]; p.w2_v = (const float*)d_in[12];
  p.w_up = (const float*)d_in[13]; p.w_out = (const float*)d_in[14]; p.ple_g = (const float*)d_in[15];
  p.w_ple = (const float*)d_in[16]; p.w_pg = (const float*)d_in[17]; p.fin_g = (const float*)d_in[18];
  p.out = (float*)d_out; p.ws = (u8*)d_ws;
  for (int j = 0; j < 8; j++) p.inv[j] = (float)pow(500000.0, -(double)(2 * j) / 16.0);
  (void)hipMemsetAsync((u8*)d_ws + WS_CTR, 0, 256, stream);
  (void)hipMemsetAsync((u8*)d_ws + WS_BAR, 0, 16384, stream);
  void* args[] = {&p};
  hipError_t e = hipLaunchCooperativeKernel((void*)fwd_megakernel, dim3(grid_blocks), dim3(256), args, 0, stream);
  if (e != hipSuccess) fprintf(stderr, "cooperative launch failed: %s (grid %d)\n", hipGetErrorString(e), grid_blocks);
}
```
